# Optimizing an MI355X kernel written in HIP

```python
import math
import jax, jax.numpy as jnp
from jax import lax
import numpy as np

D_MODEL = 1024
BATCH = 4
SEQ = 4096
DEPTH = 1

CHUNK = 64
MIX_WIDTH = D_MODEL
GMLP_WIDTH = MIX_WIDTH // 2
DIFF_WIDTH = MIX_WIDTH - GMLP_WIDTH
GMLP_GROUPS = 4
GMLP_GROUP_CH = GMLP_WIDTH // GMLP_GROUPS
GMLP_BLOCK = 128
DIFF_HEADS = 4
DIFF_HEAD_DIM = DIFF_WIDTH // (2 * DIFF_HEADS)
DIFF_V_DIM = 2 * DIFF_HEAD_DIM
ATTN_QBLOCK = 128
A_COLS = 2 * GMLP_WIDTH
Q_COLS = DIFF_HEADS * 2 * DIFF_HEAD_DIM
K_COLS = DIFF_HEADS * 2 * DIFF_HEAD_DIM
V_COLS = DIFF_HEADS * DIFF_V_DIM
IN_COLS = A_COLS + Q_COLS + K_COLS + V_COLS
REL_BUCKETS = 32
REL_MAX_EXACT = 8
REL_MAX_DIST = 128
PEER_N_KEYS = 128
PEER_EXPERTS = PEER_N_KEYS * PEER_N_KEYS
PEER_HEADS = 8
PEER_TOPK = 16
PEER_DKEY = 256
PEER_HALF = PEER_DKEY // 2
PEER_BLOCK = 128
PLE_DIM = 256
EPS = 1e-6
NEG_INF = -1e30

kernel_name = "hybrid_gmlp_diffattn_peer_ple"


def _rmsnorm(x, g):
    xf = x.astype(jnp.float32)
    y = xf * lax.rsqrt(jnp.mean(xf * xf, axis=-1, keepdims=True) + EPS)
    return (y * g.astype(jnp.float32)).astype(x.dtype)


def _layernorm(x, g, b):
    xf = x.astype(jnp.float32)
    mu = jnp.mean(xf, axis=-1, keepdims=True)
    xc = xf - mu
    y = xc * lax.rsqrt(jnp.mean(xc * xc, axis=-1, keepdims=True) + EPS)
    return (y * g.astype(jnp.float32) + b.astype(jnp.float32)).astype(x.dtype)


def _t5_bucket(rel):
    nb = REL_BUCKETS // 2
    ret = jnp.where(rel > 0, nb, 0)
    n = jnp.abs(rel)
    is_small = n < REL_MAX_EXACT
    nf = jnp.maximum(n, 1).astype(jnp.float32)
    large = REL_MAX_EXACT + (jnp.log(nf / REL_MAX_EXACT) / math.log(REL_MAX_DIST / REL_MAX_EXACT)
                             * (nb - REL_MAX_EXACT)).astype(jnp.int32)
    large = jnp.minimum(large, nb - 1)
    return ret + jnp.where(is_small, n, large)


def _gmlp_group(z, ln_g, ln_b, w_s, b_s, beta):
    B, S, _ = z.shape
    z = jax.nn.gelu(z)
    u, v = z[..., :GMLP_WIDTH], z[..., GMLP_WIDTH:]
    v = v.reshape(B, S, GMLP_GROUPS, GMLP_GROUP_CH)
    v = _layernorm(v, ln_g.reshape(GMLP_GROUPS, GMLP_GROUP_CH), ln_b.reshape(GMLP_GROUPS, GMLP_GROUP_CH))
    v = v.reshape(B, S // GMLP_BLOCK, GMLP_BLOCK, GMLP_GROUPS, GMLP_GROUP_CH)
    pos = jnp.arange(GMLP_BLOCK)
    causal = (pos[None, :] // CHUNK) <= (pos[:, None] // CHUNK)
    w = jnp.where(causal[None], w_s, jnp.zeros_like(w_s))
    sv = jnp.einsum('gij,bnjgc->bnigc', w, v) + jnp.transpose(b_s)[None, None, :, :, None]
    out = u.reshape(B, S, GMLP_GROUPS, GMLP_GROUP_CH) * sv.reshape(B, S, GMLP_GROUPS, GMLP_GROUP_CH)
    out = _rmsnorm(out, beta.reshape(GMLP_GROUPS, GMLP_GROUP_CH))
    return out.reshape(B, S, GMLP_WIDTH)


def _diff_attention(q, k, v, rel_bias, lam, lam_init, subln_g):
    B, S = q.shape[0], q.shape[1]
    nblk = S // ATTN_QBLOCK
    qb = q.reshape(B, nblk, ATTN_QBLOCK, DIFF_HEADS, 2, DIFF_HEAD_DIM)
    qb = jnp.transpose(qb, (1, 0, 2, 3, 4, 5)) * (DIFF_HEAD_DIM ** -0.5)
    kpos = jnp.arange(S)

    def one_block(args):
        q_blk, bi = args
        qpos = bi * ATTN_QBLOCK + jnp.arange(ATTN_QBLOCK)
        logits = jnp.einsum('bqhcd,bkhcd->bhcqk', q_blk, k).astype(jnp.float32)
        bias = rel_bias[_t5_bucket(kpos[None, :] - qpos[:, None])]
        bias = jnp.transpose(bias, (2, 0, 1))[None, :, None].astype(jnp.float32)
        mask = (kpos[None, :] // CHUNK) <= (qpos[:, None] // CHUNK)
        logits = jnp.where(mask, logits + bias, NEG_INF)
        probs = jax.nn.softmax(logits, axis=-1)
        attn = probs[:, :, 0] - lam * probs[:, :, 1]
        return jnp.einsum('bhqk,bkhe->bqhe', attn.astype(v.dtype), v)

    out = lax.map(one_block, (qb, jnp.arange(nblk)))
    out = jnp.transpose(out, (1, 0, 2, 3, 4)).reshape(B, S, DIFF_HEADS, DIFF_V_DIM)
    out = _rmsnorm(out, subln_g) * (1.0 - lam_init)
    return out.reshape(B, S, DIFF_WIDTH)


def _peer(x, w_q, sub_keys, u_tab, v_tab):
    B, S, D = x.shape
    T = B * S
    xb = x.reshape(T // PEER_BLOCK, PEER_BLOCK, D)

    def one(xt):
        q = (xt @ w_q).reshape(PEER_BLOCK, PEER_HEADS, 2, PEER_HALF)
        s = jnp.einsum('thcd,hcnd->thcn', q, sub_keys).astype(jnp.float32)
        s1, i1 = lax.top_k(s[:, :, 0], PEER_TOPK)
        s2, i2 = lax.top_k(s[:, :, 1], PEER_TOPK)
        cand = (s1[..., :, None] + s2[..., None, :]).reshape(PEER_BLOCK, PEER_HEADS, PEER_TOPK * PEER_TOPK)
        cidx = (i1[..., :, None] * PEER_N_KEYS + i2[..., None, :]).reshape(PEER_BLOCK, PEER_HEADS, PEER_TOPK * PEER_TOPK)
        best, pos = lax.top_k(cand, PEER_TOPK)
        eid = jnp.take_along_axis(cidx, pos, axis=-1)
        gate = jax.nn.softmax(best, axis=-1)
        u_sel = u_tab[eid]
        act = jax.nn.gelu(jnp.einsum('thkd,td->thk', u_sel, xt).astype(jnp.float32))
        v_sel = v_tab[eid]
        return jnp.einsum('thk,thkd->td', (gate * act).astype(xt.dtype), v_sel)

    return lax.map(one, xb).reshape(B, S, D)


def setup_inputs(seed: int = 0) -> dict:
    key = jax.random.key(seed)
    ks = jax.random.split(key, 32)
    f32 = jnp.float32
    nrm = lambda k, shape, scale: jax.random.normal(k, shape, f32) * scale
    gain = lambda k, shape: 1.0 + 0.02 * jax.random.normal(k, shape, f32)
    return {
        'x': jax.random.normal(ks[0], (BATCH, SEQ, D_MODEL), f32),
        'p': jax.random.normal(ks[1], (DEPTH, BATCH, SEQ, PLE_DIM), f32),
        'g_mix': gain(ks[2], (DEPTH, D_MODEL)),
        'w_in': nrm(ks[3], (DEPTH, D_MODEL, IN_COLS), D_MODEL ** -0.5),
        'gmlp_ln_g': gain(ks[4], (DEPTH, GMLP_WIDTH)),
        'gmlp_ln_b': nrm(ks[5], (DEPTH, GMLP_WIDTH), 0.02),
        'gmlp_w_s': nrm(ks[6], (DEPTH, GMLP_GROUPS, GMLP_BLOCK, GMLP_BLOCK), GMLP_BLOCK ** -0.5),
        'gmlp_b_s': 1.0 + nrm(ks[7], (DEPTH, GMLP_GROUPS, GMLP_BLOCK), 0.02),
        'gmlp_beta': gain(ks[8], (DEPTH, GMLP_WIDTH)),
        'lambda_q1': nrm(ks[9], (DEPTH, DIFF_HEAD_DIM), 0.1),
        'lambda_k1': nrm(ks[10], (DEPTH, DIFF_HEAD_DIM), 0.1),
        'lambda_q2': nrm(ks[11], (DEPTH, DIFF_HEAD_DIM), 0.1),
        'lambda_k2': nrm(ks[12], (DEPTH, DIFF_HEAD_DIM), 0.1),
        'subln_g': gain(ks[13], (DEPTH, DIFF_V_DIM)),
        'rel_bias': nrm(ks[14], (REL_BUCKETS, DIFF_HEADS), 0.5),
        'w_out': nrm(ks[15], (DEPTH, MIX_WIDTH, D_MODEL), MIX_WIDTH ** -0.5),
        'g_ffn': gain(ks[16], (DEPTH, D_MODEL)),
        'peer_w_q': nrm(ks[17], (DEPTH, D_MODEL, PEER_HEADS * PEER_DKEY), D_MODEL ** -0.5),
        'peer_keys': nrm(ks[18], (DEPTH, PEER_HEADS, 2, PEER_N_KEYS, PEER_HALF), PEER_HALF ** -0.5),
        'peer_u': nrm(ks[19], (DEPTH, PEER_EXPERTS, D_MODEL), D_MODEL ** -0.5),
        'peer_v': nrm(ks[20], (DEPTH, PEER_EXPERTS, D_MODEL), PEER_HEADS ** -0.5),
        'g_ple': gain(ks[21], (DEPTH, D_MODEL)),
        'w_ple': nrm(ks[22], (DEPTH, PLE_DIM, D_MODEL), PLE_DIM ** -0.5),
        'w_gate': nrm(ks[23], (DEPTH, D_MODEL, D_MODEL), D_MODEL ** -0.5),
        'g_final': gain(ks[24], (D_MODEL,)),
    }


def reference(x, p, g_mix, w_in, gmlp_ln_g, gmlp_ln_b, gmlp_w_s, gmlp_b_s, gmlp_beta,
              lambda_q1, lambda_k1, lambda_q2, lambda_k2, subln_g, rel_bias, w_out,
              g_ffn, peer_w_q, peer_keys, peer_u, peer_v, g_ple, w_ple, w_gate, g_final):
    B, S, _ = x.shape
    h = x
    for i in range(DEPTH):
        lam_init = 0.8 - 0.6 * math.exp(-0.3 * i)
        n1 = _rmsnorm(h, g_mix[i])
        z = n1 @ w_in[i]
        z_a = z[..., :A_COLS]
        q = z[..., A_COLS:A_COLS + Q_COLS].reshape(B, S, DIFF_HEADS, 2, DIFF_HEAD_DIM)
        k = z[..., A_COLS + Q_COLS:A_COLS + Q_COLS + K_COLS].reshape(B, S, DIFF_HEADS, 2, DIFF_HEAD_DIM)
        v = z[..., A_COLS + Q_COLS + K_COLS:].reshape(B, S, DIFF_HEADS, DIFF_V_DIM)
        out_a = _gmlp_group(z_a, gmlp_ln_g[i], gmlp_ln_b[i], gmlp_w_s[i], gmlp_b_s[i], gmlp_beta[i])
        lam = (jnp.exp(jnp.sum(lambda_q1[i].astype(jnp.float32) * lambda_k1[i].astype(jnp.float32)))
               - jnp.exp(jnp.sum(lambda_q2[i].astype(jnp.float32) * lambda_k2[i].astype(jnp.float32)))
               + lam_init)
        out_b = _diff_attention(q, k, v, rel_bias, lam, lam_init, subln_g[i])
        h = h + jnp.concatenate([out_a, out_b], axis=-1) @ w_out[i]
        h = h + _peer(_rmsnorm(h, g_ffn[i]), peer_w_q[i], peer_keys[i], peer_u[i], peer_v[i])
        gate = jax.nn.sigmoid((_rmsnorm(h, g_ple[i]) @ w_gate[i]).astype(jnp.float32)).astype(h.dtype)
        h = h + (p[i] @ w_ple[i]) * gate
    return _rmsnorm(h, g_final)
```

```cpp
#include <hip/hip_runtime.h>
#include <cstdio>
#include <cstdint>
namespace pg8 {
#define PG8_LAS __attribute__((address_space(3)))
typedef unsigned short bf16_t;
typedef short bf16x8 __attribute__((ext_vector_type(8)));
typedef float f32x4 __attribute__((ext_vector_type(4)));
typedef unsigned u32x4 __attribute__((ext_vector_type(4)));
constexpr int BM = 256, BK = 64, HALF = 128, HTB = HALF * BK * 2  , STAGE_BYTES = 8 * HTB, NXCD = 8, WGM = 8;

__host__ __device__ __forceinline__ int lds_byte(int r, int c) { const int st = (r >> 4) * 2 + (c >> 5), rr = r & 15, cc = c & 31, ob = rr * 64 + cc * 2; return st * 1024 + (ob ^ (((ob >> 9) & 1) << 5)); }
__host__ __device__ __forceinline__ void stage_rc(int b, int& R, int& C) { const int st = b / 1024, sb = b % 1024, swz = sb ^ (((sb >> 9) & 1) << 5); R = (st >> 1) * 16 + swz / 64; C = (st & 1) * 32 + (swz % 64) / 2; }
__host__ __device__ __forceinline__ int perm32(int rho) { const int n = rho >> 4, i = rho & 15; return 8 * (i >> 2) + 4 * n + (i & 3); }

struct Unit { int pm, pn; };
struct Gemm { const bf16_t* A; const bf16_t* Bt; int M, N, K; };

struct StaticOrder {
    int nM, nN, nwg, G, c;
    __host__ __device__ void init(int M, int N, int G_, int c_) { nM = M / BM; nN = N / BM; nwg = nM * nN; G = G_; c = c_; }
    __host__ __device__ bool next(int i, Unit& u) const {
        const long L = (long)i * G + c; if (L >= nwg) return false;
        int wgid = (int)L; { const int q = nwg / NXCD, r = nwg % NXCD, xcd = wgid % NXCD, off = wgid / NXCD; wgid = (xcd < r ? xcd * (q + 1) : r * (q + 1) + (xcd - r) * q) + off; }
        const int nig = WGM * nN, gid = wgid / nig, fm = gid * WGM, gsz = (nM - fm) < WGM ? (nM - fm) : WGM;
        u.pm = fm + ((wgid % nig) % gsz); u.pn = (wgid % nig) / gsz; return true;
    }
    __device__ __forceinline__ void a_ready(const Unit&) const {}
    __device__ __forceinline__ void done(const Unit&) const {}
};


__device__ __forceinline__ unsigned cvt_pk_bf16(float lo, float hi) { unsigned r; asm volatile("v_cvt_pk_bf16_f32 %0, %1, %2" : "=v"(r) : "v"(lo), "v"(hi)); return r; }
typedef unsigned u32x2 __attribute__((ext_vector_type(2)));
__device__ __forceinline__ float gelu_tanh(float x) {
    const float t = x * (1.0f + 0.044715f * x * x) * (-2.3022082f);
    return x * __builtin_amdgcn_rcpf(1.0f + __builtin_amdgcn_exp2f(t));
}
__device__ __forceinline__ float bf_lo(unsigned w) { return __uint_as_float(w << 16); }
__device__ __forceinline__ float bf_hi(unsigned w) { return __uint_as_float(w & 0xffff0000u); }

struct EpiZ {
    static constexpr bool PERM = true, AFTER_DRAIN = false;
    bf16_t *zA, *q, *k, *v; const float* rs; float qscale;
    __device__ __forceinline__ void operator()(const f32x4 (&acc)[2][2][4][2], const Unit& u, int wr, int wc, int fr, int fq) const {
        const int pn = u.pn; bf16_t* base; int ldc, colt; float sc = 1.f; bool act = false;
        if (pn < 4) { base = zA; ldc = 1024; colt = pn * BM; act = true; }
        else if (pn < 6) { base = q; ldc = 512; colt = (pn - 4) * BM; sc = qscale; }
        else if (pn < 8) { base = k; ldc = 512; colt = (pn - 6) * BM; }
        else { base = v; ldc = 512; colt = (pn - 8) * BM; }
        const int row0 = u.pm * BM + wr * 64 + fr, col0 = colt + wc * 32 + 8 * fq;
#pragma unroll
        for (int ai = 0; ai < 2; ++ai)
#pragma unroll
            for (int m = 0; m < 4; ++m) { const int r = row0 + ai * HALF + m * 16; const float s = rs[r] * sc; bf16_t* rowp = base + (size_t)r * ldc + col0;
#pragma unroll
                for (int bj = 0; bj < 2; ++bj) { f32x4 v0 = acc[ai][bj][m][0] * s, v1 = acc[ai][bj][m][1] * s;
                    if (act) {
#pragma unroll
                        for (int j = 0; j < 4; ++j) { v0[j] = gelu_tanh(v0[j]); v1[j] = gelu_tanh(v1[j]); } }
                    u32x4 w; w.x = cvt_pk_bf16(v0[0], v0[1]); w.y = cvt_pk_bf16(v0[2], v0[3]); w.z = cvt_pk_bf16(v1[0], v1[1]); w.w = cvt_pk_bf16(v1[2], v1[3]);
                    *(u32x4*)(rowp + bj * HALF) = w; }
                asm volatile("" ::: "memory"); }
    }
};
struct EpiBf {
    static constexpr bool PERM = true, AFTER_DRAIN = false;
    bf16_t* O; int ldc;
    __device__ __forceinline__ void operator()(const f32x4 (&acc)[2][2][4][2], const Unit& u, int wr, int wc, int fr, int fq) const {
        const int row0 = u.pm * BM + wr * 64 + fr, col0 = u.pn * BM + wc * 32 + 8 * fq;
#pragma unroll
        for (int ai = 0; ai < 2; ++ai)
#pragma unroll
            for (int m = 0; m < 4; ++m) { bf16_t* rowp = O + (size_t)(row0 + ai * HALF + m * 16) * ldc + col0;
#pragma unroll
                for (int bj = 0; bj < 2; ++bj) { const f32x4 v0 = acc[ai][bj][m][0], v1 = acc[ai][bj][m][1];
                    u32x4 w; w.x = cvt_pk_bf16(v0[0], v0[1]); w.y = cvt_pk_bf16(v0[2], v0[3]); w.z = cvt_pk_bf16(v1[0], v1[1]); w.w = cvt_pk_bf16(v1[2], v1[3]);
                    *(u32x4*)(rowp + bj * HALF) = w; } }
    }
};
struct EpiRes {
    static constexpr bool PERM = false, AFTER_DRAIN = false;
    const float* base; float* out; bf16_t* hb; float* part;
    __device__ __forceinline__ void operator()(const f32x4 (&acc)[2][2][4][2], const Unit& u, int wr, int wc, int fr, int fq) const {
        const int row0 = u.pm * BM + wr * 64 + fr, col0 = u.pn * BM + wc * 32 + 4 * fq;
#pragma unroll
        for (int ai = 0; ai < 2; ++ai)
#pragma unroll
            for (int m = 0; m < 4; ++m) { const int r = row0 + ai * HALF + m * 16; const size_t off = (size_t)r * 1024 + col0; float ss = 0.f;
#pragma unroll
                for (int bj = 0; bj < 2; ++bj)
#pragma unroll
                    for (int n = 0; n < 2; ++n) { const size_t o = off + bj * HALF + n * 16; const f32x4 b = *(const f32x4*)(base + o); const f32x4 h = b + acc[ai][bj][m][n];
                        *(f32x4*)(out + o) = h; ss += (h[0] * h[0] + h[1] * h[1]) + (h[2] * h[2] + h[3] * h[3]);
                        u32x2 w; w.x = cvt_pk_bf16(h[0], h[1]); w.y = cvt_pk_bf16(h[2], h[3]); *(u32x2*)(hb + o) = w; }
                ss += __shfl_xor(ss, 16); ss += __shfl_xor(ss, 32);
                if (fq == 0) part[(size_t)r * 16 + u.pn * 4 + wc] = ss; }
    }
};
struct EpiGate {
    static constexpr bool PERM = false, AFTER_DRAIN = false;
    float* hio; const bf16_t* ple; const float* rs; float* part;
    __device__ __forceinline__ void operator()(const f32x4 (&acc)[2][2][4][2], const Unit& u, int wr, int wc, int fr, int fq) const {
        const int row0 = u.pm * BM + wr * 64 + fr, col0 = u.pn * BM + wc * 32 + 4 * fq;
#pragma unroll
        for (int ai = 0; ai < 2; ++ai)
#pragma unroll
            for (int m = 0; m < 4; ++m) { const int r = row0 + ai * HALF + m * 16; const size_t off = (size_t)r * 1024 + col0; float ss = 0.f; const float s = rs[r] * (-1.44269504f);
#pragma unroll
                for (int bj = 0; bj < 2; ++bj)
#pragma unroll
                    for (int n = 0; n < 2; ++n) { const size_t o = off + bj * HALF + n * 16; f32x4 h = *(const f32x4*)(hio + o); const u32x2 pw = *(const u32x2*)(ple + o);
                        const f32x4 a = acc[ai][bj][m][n]; f32x4 g;
#pragma unroll
                        for (int j = 0; j < 4; ++j) g[j] = __builtin_amdgcn_rcpf(1.0f + __builtin_amdgcn_exp2f(a[j] * s));
                        h[0] += bf_lo(pw.x) * g[0]; h[1] += bf_hi(pw.x) * g[1]; h[2] += bf_lo(pw.y) * g[2]; h[3] += bf_hi(pw.y) * g[3];
                        *(f32x4*)(hio + o) = h; ss += (h[0] * h[0] + h[1] * h[1]) + (h[2] * h[2] + h[3] * h[3]); }
                ss += __shfl_xor(ss, 16); ss += __shfl_xor(ss, 32);
                if (fq == 0) part[(size_t)r * 16 + u.pn * 4 + wc] = ss; }
    }
};

template <class Epi, class Sched, bool ALIGN_EPI = false, bool SP2 = false>
__device__ __forceinline__ void gemm_phase(PG8_LAS unsigned char* lds, const Gemm g, const Sched& S, const Epi& E) {
    const int tid = threadIdx.x, wid = __builtin_amdgcn_readfirstlane(tid >> 6), lane = tid & 63, wr = wid >> 2, wc = wid & 3, fr = lane & 15, fq = lane >> 4;
    const int K = g.K, nt = K / BK;
    unsigned voffA[2], voffB[2];
#pragma unroll
    for (int i = 0; i < 2; ++i) { int R, C; stage_rc(tid * 16 + i * 8192, R, C); const int Rb = Epi::PERM ? ((R & ~31) + perm32(R & 31)) : R;
        voffA[i] = (unsigned)(R * K + C) * 2u; voffB[i] = (unsigned)(Rb * K + C) * 2u; }
    const size_t kstep = (size_t)(BK * 2);
    const size_t hstep = (size_t)HALF * K * 2;
    const size_t tstep = 2 * hstep;
    const unsigned ldsw = (unsigned)wid * 1024u;
    const int aoff = lds_byte(wr * 64 + fr, fq * 8), boff = lds_byte(wc * 32 + fr, fq * 8);
#define PG8_SA(b, h) (((b) * 2 + (h)) * HTB)
#define PG8_SB(b, h) ((4 + (b) * 2 + (h)) * HTB)
#define PG8_STAGE(bufoff, gbase, voff) do { _Pragma("unroll") for (int _i = 0; _i < 2; ++_i) \
        __builtin_amdgcn_global_load_lds((const unsigned*)((const char*)(gbase) + (voff)[_i]), (PG8_LAS unsigned*)(lds + (bufoff) + ldsw + _i * 8192), 16, 0, 0); } while (0)
#define PG8_LDA(dst, b, h) do { _Pragma("unroll") for (int m = 0; m < 4; ++m) _Pragma("unroll") for (int k = 0; k < 2; ++k) dst[m][k] = *(const PG8_LAS bf16x8*)(lds + PG8_SA(b, h) + aoff + m * 2048 + k * 1024); } while (0)
#define PG8_LDB(dst, b, h) do { _Pragma("unroll") for (int n = 0; n < 2; ++n) _Pragma("unroll") for (int k = 0; k < 2; ++k) dst[n][k] = *(const PG8_LAS bf16x8*)(lds + PG8_SB(b, h) + boff + n * 2048 + k * 1024); } while (0)
#define PG8_MMA(ai, bj, At, Bt) do { __builtin_amdgcn_s_setprio(1); _Pragma("unroll") for (int m = 0; m < 4; ++m) _Pragma("unroll") for (int n = 0; n < 2; ++n) _Pragma("unroll") for (int k = 0; k < 2; ++k) \
        acc[ai][bj][m][n] = __builtin_amdgcn_mfma_f32_16x16x32_bf16(Bt[n][k], At[m][k], acc[ai][bj][m][n], 0, 0, 0); __builtin_amdgcn_s_setprio(0); } while (0)
#define PG8_WAIT_V(n) asm volatile("s_waitcnt vmcnt(" #n ")" ::: "memory")
#define PG8_WAIT_L(n) asm volatile("s_waitcnt lgkmcnt(" #n ")" ::: "memory")
#define PG8_BAR __builtin_amdgcn_s_barrier()
#define PG8_SCHED __builtin_amdgcn_sched_barrier(0)
    Unit cur, nxt; int ui = 0;
    if (!S.next(0, cur)) return;
    f32x4 acc[2][2][4][2];
#pragma unroll
    for (int a = 0; a < 2; ++a)
#pragma unroll
        for (int b = 0; b < 2; ++b)
#pragma unroll
            for (int m = 0; m < 4; ++m)
#pragma unroll
                for (int n = 0; n < 2; ++n) acc[a][b][m][n] = (f32x4){0.f, 0.f, 0.f, 0.f};
    bf16x8 At[4][2], B0[2][2], B1[2][2];
    const char* cA = (const char*)g.A + (size_t)cur.pm * tstep; const char* cB = (const char*)g.Bt + (size_t)cur.pn * tstep;
    S.a_ready(cur);
    if constexpr (SP2) {
        PG8_STAGE(PG8_SB(0, 0), cB, voffB); PG8_STAGE(PG8_SB(0, 1), cB + hstep, voffB); PG8_STAGE(PG8_SA(0, 0), cA, voffA); PG8_STAGE(PG8_SA(0, 1), cA + hstep, voffA);
        if (wr == 1) PG8_BAR;
        PG8_WAIT_V(2); PG8_BAR;
        PG8_STAGE(PG8_SB(1, 0), cB + kstep, voffB); PG8_STAGE(PG8_SA(1, 0), cA + kstep, voffA); PG8_STAGE(PG8_SB(1, 1), cB + hstep + kstep, voffB);
        PG8_WAIT_V(6); PG8_BAR;
    } else {
        PG8_STAGE(PG8_SB(0, 0), cB, voffB); PG8_STAGE(PG8_SA(0, 0), cA, voffA); PG8_STAGE(PG8_SB(0, 1), cB + hstep, voffB); PG8_STAGE(PG8_SA(0, 1), cA + hstep, voffA);
        if (wr == 1) PG8_BAR;
        PG8_WAIT_V(4); PG8_BAR;
        PG8_STAGE(PG8_SB(1, 0), cB + kstep, voffB); PG8_STAGE(PG8_SA(1, 0), cA + kstep, voffA); PG8_STAGE(PG8_SB(1, 1), cB + hstep + kstep, voffB);
        PG8_WAIT_V(6); PG8_BAR;
    }
    for (;;) {
        const bool has_next = S.next(ui + 1, nxt);
        const char* nA = has_next ? (const char*)g.A + (size_t)nxt.pm * tstep : cA; const char* nB = has_next ? (const char*)g.Bt + (size_t)nxt.pn * tstep : cB;
        for (int t = 0; t < nt; t += 2) {
            const bool last = (t == nt - 2);
            const char* a1 = cA + (size_t)(t + 1) * kstep;
            const char* a2 = last ? nA : cA + (size_t)(t + 2) * kstep; const char* b2 = last ? nB : cB + (size_t)(t + 2) * kstep;
            const char* a3 = a2 + kstep; const char* b3 = b2 + kstep;
            if (last && has_next) S.a_ready(nxt);
            if constexpr (SP2) {
            PG8_LDB(B0, 0, 0); PG8_LDB(B1, 0, 1); PG8_SCHED; PG8_LDA(At, 0, 0); PG8_STAGE(PG8_SA(1, 1), a1 + hstep, voffA);
            PG8_WAIT_V(8); PG8_WAIT_L(0); PG8_BAR; PG8_MMA(0, 0, At, B0); PG8_MMA(0, 1, At, B1); PG8_BAR; PG8_SCHED;
            PG8_LDA(At, 0, 1); PG8_STAGE(PG8_SB(0, 0), b2, voffB); PG8_STAGE(PG8_SB(0, 1), b2 + hstep, voffB); PG8_STAGE(PG8_SA(0, 0), a2, voffA);
            PG8_WAIT_V(8); PG8_WAIT_L(0); PG8_BAR; PG8_MMA(1, 0, At, B0); PG8_MMA(1, 1, At, B1); PG8_BAR; PG8_SCHED;
            PG8_LDB(B0, 1, 0); PG8_LDB(B1, 1, 1); PG8_SCHED; PG8_LDA(At, 1, 0); PG8_STAGE(PG8_SA(0, 1), a2 + hstep, voffA);
            PG8_WAIT_V(8); PG8_WAIT_L(0); PG8_BAR; PG8_MMA(0, 0, At, B0); PG8_MMA(0, 1, At, B1); PG8_BAR; PG8_SCHED;
            PG8_LDA(At, 1, 1); PG8_STAGE(PG8_SB(1, 0), b3, voffB); PG8_STAGE(PG8_SB(1, 1), b3 + hstep, voffB); PG8_STAGE(PG8_SA(1, 0), a3, voffA);
            PG8_WAIT_V(8); PG8_WAIT_L(0); PG8_BAR; PG8_MMA(1, 0, At, B0); PG8_MMA(1, 1, At, B1); PG8_BAR; PG8_SCHED;
            } else {
            PG8_LDB(B0, 0, 0); PG8_SCHED; PG8_LDA(At, 0, 0); PG8_STAGE(PG8_SA(1, 1), a1 + hstep, voffA);
            PG8_WAIT_L(8); PG8_BAR; PG8_WAIT_L(0); PG8_MMA(0, 0, At, B0); PG8_BAR; PG8_SCHED;
            PG8_LDB(B1, 0, 1); PG8_STAGE(PG8_SB(0, 0), b2, voffB);
            PG8_BAR; PG8_WAIT_L(0); PG8_MMA(0, 1, At, B1); PG8_BAR;
            PG8_LDA(At, 0, 1); PG8_STAGE(PG8_SA(0, 0), a2, voffA);
            PG8_BAR; PG8_WAIT_L(0); PG8_MMA(1, 0, At, B0); PG8_BAR; PG8_SCHED;
            PG8_STAGE(PG8_SB(0, 1), b2 + hstep, voffB);
            PG8_WAIT_V(6); PG8_BAR; PG8_MMA(1, 1, At, B1); PG8_BAR;
            PG8_LDB(B0, 1, 0); PG8_SCHED; PG8_LDA(At, 1, 0); PG8_STAGE(PG8_SA(0, 1), a2 + hstep, voffA);
            PG8_WAIT_L(8); PG8_BAR; PG8_WAIT_L(0); PG8_MMA(0, 0, At, B0); PG8_BAR; PG8_SCHED;
            PG8_LDB(B1, 1, 1); PG8_STAGE(PG8_SB(1, 0), b3, voffB);
            PG8_BAR; PG8_WAIT_L(0); PG8_MMA(0, 1, At, B1); PG8_BAR;
            PG8_LDA(At, 1, 1); PG8_STAGE(PG8_SA(1, 0), a3, voffA);
            PG8_BAR; PG8_WAIT_L(0); PG8_MMA(1, 0, At, B0); PG8_BAR; PG8_SCHED;
            PG8_STAGE(PG8_SB(1, 1), b3 + hstep, voffB);
            PG8_WAIT_V(6); PG8_BAR; PG8_MMA(1, 1, At, B1); PG8_BAR;
            }
        }
        if constexpr (ALIGN_EPI) { if (wr == 0) PG8_BAR; }
        if constexpr (!Epi::AFTER_DRAIN) { E(acc, cur, wr, wc, fr, fq); S.done(cur); }
        if (!has_next) break;
#pragma unroll
        for (int a = 0; a < 2; ++a)
#pragma unroll
            for (int b = 0; b < 2; ++b)
#pragma unroll
                for (int m = 0; m < 4; ++m)
#pragma unroll
                    for (int n = 0; n < 2; ++n) acc[a][b][m][n] = (f32x4){0.f, 0.f, 0.f, 0.f};
        cur = nxt; cA = nA; cB = nB; ++ui;
        if constexpr (ALIGN_EPI) { if (wr == 1) PG8_BAR; }
    }
    PG8_WAIT_V(0);
    if constexpr (!ALIGN_EPI) { if (wr == 0) PG8_BAR; }
    PG8_BAR;
    if constexpr (Epi::AFTER_DRAIN) { E.fused(acc, cur, wr, wc, fr, fq, lds, wid, lane); S.done(cur); }
#undef PG8_SA
#undef PG8_SB
#undef PG8_STAGE
#undef PG8_LDA
#undef PG8_LDB
#undef PG8_MMA
#undef PG8_WAIT_V
#undef PG8_WAIT_L
#undef PG8_BAR
#undef PG8_SCHED
}
}

constexpr int NWAVES = 8;
#ifndef MK_N_LAUNCHES
#define MK_N_LAUNCHES 1
#endif
constexpr int NPHASE = 8;
constexpr int N_LAUNCHES = MK_N_LAUNCHES;

constexpr int T = 16384, D = 1024, SEQ = 4096;
constexpr float EPS = 1e-6f;
constexpr size_t MiB = 1u << 20;
constexpr size_t WS_CTL = 0, CTL_ZERO_BYTES = 16384;
constexpr size_t WS_WIN = 1 * MiB, WS_WOUT = 6 * MiB, WS_WQ = 8 * MiB, WS_WGATE = 12 * MiB, WS_WPLE = 14 * MiB;
constexpr size_t WS_RS1 = 14 * MiB + 512 * 1024, WS_RS3 = WS_RS1 + 65536, WS_PART4 = 15 * MiB, WS_PART2 = 16 * MiB;
constexpr size_t WS_A = 17 * MiB;
constexpr size_t WS_PB = 49 * MiB;
constexpr size_t WS_PLE = 57 * MiB;
constexpr size_t WS_TAB = 89 * MiB;
constexpr size_t WS_SEL = 153 * MiB;
constexpr size_t WS_M = 169 * MiB;
constexpr size_t WS_F = 201 * MiB;
constexpr size_t WS_END = 256 * MiB;
constexpr int RING_BYTES = 131072, MISC_OFF = RING_BYTES + 320, LDS_BYTES = 147456;

#define GAS __attribute__((address_space(1)))
#define LAS __attribute__((address_space(3)))
typedef unsigned short bf16;
typedef unsigned v4u __attribute__((ext_vector_type(4)));
typedef unsigned v2u __attribute__((ext_vector_type(2)));
typedef float f32x4 __attribute__((ext_vector_type(4)));
#define LDS_WAIT() asm volatile("s_waitcnt lgkmcnt(0)" ::: "memory")
__device__ __forceinline__ unsigned f2bf(float f) { unsigned u = __builtin_bit_cast(unsigned, f); return (u + 0x7fffu + ((u >> 16) & 1u)) >> 16; }
__device__ __forceinline__ unsigned pk2(float lo, float hi) { return f2bf(lo) | (f2bf(hi) << 16); }
__device__ __forceinline__ float blo(unsigned w) { return __uint_as_float(w << 16); }
__device__ __forceinline__ float bhi(unsigned w) { return __uint_as_float(w & 0xffff0000u); }
__device__ __forceinline__ float wave_sum(float v) {
#pragma unroll
    for (int o = 1; o < 64; o <<= 1) v += __shfl_xor(v, o);
    return v;
}
__device__ __forceinline__ float dot4(f32x4 a, f32x4 b) { return (a[0] * b[0] + a[1] * b[1]) + (a[2] * b[2] + a[3] * b[3]); }

#define XB_TMO      128
#define XB_XCNT(j)  (256  + 64 * (j))
#define XB_XSUB(j)  (1280 + 64 * (j))
#define XB_XGEN(j)  (2304 + 64 * (j))
#define XB_TOP      3328
#define XB_TOPGEN   3392
#define XCD_BAR_WORDS 3456
#define XB_SPIN_CAP (1u << 18)

__device__ __forceinline__ unsigned xb_ld(unsigned* p)              { return __hip_atomic_load(p, __ATOMIC_RELAXED, __HIP_MEMORY_SCOPE_AGENT); }
__device__ __forceinline__ unsigned xb_add(unsigned* p, unsigned v) { return __hip_atomic_fetch_add(p, v, __ATOMIC_RELAXED, __HIP_MEMORY_SCOPE_AGENT); }
__device__ __forceinline__ unsigned xb_xcc_id() { return (unsigned)__builtin_amdgcn_s_getreg((3 << 11) | 20) & 0xFu; }
#define XB_SPIN(cond, bar) do { unsigned _sp = 0; while (cond) { __builtin_amdgcn_s_sleep(1); \
    if ((++_sp & 255u) == 0u) { if (xb_ld(&(bar)[XB_TMO])) break; if (_sp > XB_SPIN_CAP) { atomicAdd(&(bar)[XB_TMO], 1u); break; } } } } while (0)

struct XcdBarrier {
    unsigned* bar; unsigned x;
    volatile LAS unsigned* st;
};

__device__ __forceinline__ XcdBarrier xcd_barrier_post(unsigned* bar, volatile LAS unsigned* st) {
    XcdBarrier b; b.bar = bar; b.x = xb_xcc_id(); b.st = st;
    if (threadIdx.x == 0) (void)xb_add(&bar[XB_XCNT(b.x)], 1u);
    return b;
}
__device__ __forceinline__ void xcd_barrier_complete(unsigned* bar, unsigned x, unsigned& nloc, unsigned& nx) {
    const unsigned G = gridDim.x * gridDim.y * gridDim.z;
    unsigned sum, cnt, mine, sp = 0u;
    for (;;) {
        sum = 0u; cnt = 0u; mine = 0u;
#pragma unroll
        for (unsigned j = 0; j < 16; ++j) { const unsigned c = xb_ld(&bar[XB_XCNT(j)]); sum += c; cnt += (c > 0u) ? 1u : 0u; mine = (j == x) ? c : mine; }
        if (sum == G) break;
        __builtin_amdgcn_s_sleep(1);
        if ((++sp & 255u) == 0u) { if (xb_ld(&bar[XB_TMO])) break; if (sp > XB_SPIN_CAP) { atomicAdd(&bar[XB_TMO], 1u); break; } }
    }
    nloc = mine > 0u ? mine : 1u; nx = cnt > 0u ? cnt : 1u;
}

__device__ __forceinline__ void xcd_barrier(const XcdBarrier& b) {
    asm volatile("s_waitcnt vmcnt(0)" ::: "memory");
    __syncthreads();
    if (threadIdx.x == 0) {
        unsigned* bar = b.bar;
        __builtin_amdgcn_s_waitcnt(0);
        unsigned nloc = b.st[0], nx = b.st[1];
        if (nloc == 0u) { xcd_barrier_complete(bar, b.x, nloc, nx); b.st[0] = nloc; b.st[1] = nx; }
        const unsigned old = xb_add(&bar[XB_XSUB(b.x)], 1u);
        const unsigned gen = old / nloc;
        if (old + 1u == (gen + 1u) * nloc) {
            __builtin_amdgcn_fence(__ATOMIC_RELEASE, "agent");
            asm volatile("s_waitcnt vmcnt(0)" ::: "memory");
            const unsigned og = xb_add(&bar[XB_TOP], 1u);
            const unsigned tg = og / nx;
            if (og + 1u == (tg + 1u) * nx) xb_add(&bar[XB_TOPGEN], 1u);
            else XB_SPIN(xb_ld(&bar[XB_TOPGEN]) == tg, bar);
            __builtin_amdgcn_fence(__ATOMIC_ACQUIRE, "agent");
            xb_add(&bar[XB_XGEN(b.x)], 1u);
            asm volatile("s_waitcnt vmcnt(0)" ::: "memory");
        } else {
            XB_SPIN(xb_ld(&bar[XB_XGEN(b.x)]) == gen, bar);
            __builtin_amdgcn_fence(__ATOMIC_ACQUIRE, "agent");
            asm volatile("s_waitcnt vmcnt(0)" ::: "memory");
        }
    }
    __syncthreads();
}

__device__ __forceinline__ void p0_transpose_item(const float* W, const float* gain, int K, int N, bf16* WT, LAS float* scr, int item, int lane) {
    const int nblk = N / 32, kb = item / nblk, nb = item % nblk, k0 = 64 * kb, n0 = 32 * nb;
#pragma unroll 8
    for (int i = 0; i < 32; ++i) { const int kk = 2 * i + (lane >> 5); const float g = gain ? gain[k0 + kk] : 1.0f; scr[kk * 33 + (lane & 31)] = W[(size_t)(k0 + kk) * N + n0 + (lane & 31)] * g; }
    LDS_WAIT(); asm volatile("" ::: "memory");
    const int c = lane & 7;
#pragma unroll
    for (int j = 0; j < 4; ++j) { const int n = (lane >> 3) + 8 * j; const LAS float* s = scr + (8 * c) * 33 + n;
        v4u o; o.x = pk2(s[0 * 33], s[1 * 33]); o.y = pk2(s[2 * 33], s[3 * 33]); o.z = pk2(s[4 * 33], s[5 * 33]); o.w = pk2(s[6 * 33], s[7 * 33]);
        *(v4u*)(WT + (size_t)(n0 + n) * K + k0 + 8 * c) = o; }
    LDS_WAIT(); asm volatile("" ::: "memory");
}

__device__ __forceinline__ int t5_bucket(int rel) {
    const int n = rel < 0 ? -rel : rel;
    const int large = 8 + (n >= 12) + (n >= 16) + (n >= 23) + (n >= 32) + (n >= 46) + (n >= 64) + (n >= 91);
    return (rel > 0 ? 16 : 0) + (n < 8 ? n : large);
}

__device__ __forceinline__ void gmlp_unit(LAS unsigned char* lds, int nb, int g, const bf16* zA, const float* ln_g, const float* ln_b, const float* w_s, const float* b_s, const float* beta, bf16* mix, int tid) {
    constexpr int VP = 132;
    LAS float* vln = (LAS float*)lds;
    const int i = tid >> 2, cq = tid & 3, t = nb * 128 + i, cb = g * 128 + cq * 32;
    float x[32];
    { const v4u* vp = (const v4u*)(zA + (size_t)t * 1024 + 512 + cb);
#pragma unroll
      for (int k = 0; k < 4; ++k) { const v4u w = vp[k]; x[8 * k + 0] = blo(w.x); x[8 * k + 1] = bhi(w.x); x[8 * k + 2] = blo(w.y); x[8 * k + 3] = bhi(w.y); x[8 * k + 4] = blo(w.z); x[8 * k + 5] = bhi(w.z); x[8 * k + 6] = blo(w.w); x[8 * k + 7] = bhi(w.w); } }
    float s = 0.f;
#pragma unroll
    for (int c = 0; c < 32; ++c) s += x[c];
    s += __shfl_xor(s, 1); s += __shfl_xor(s, 2);
    const float mean = s * (1.0f / 128.0f); float q = 0.f;
#pragma unroll
    for (int c = 0; c < 32; ++c) { x[c] -= mean; q += x[c] * x[c]; }
    q += __shfl_xor(q, 1); q += __shfl_xor(q, 2);
    const float rstd = 1.0f / sqrtf(q * (1.0f / 128.0f) + EPS);
#pragma unroll
    for (int k = 0; k < 8; ++k) { const f32x4 gg = *(const f32x4*)(ln_g + cb + 4 * k), bb = *(const f32x4*)(ln_b + cb + 4 * k); f32x4 y;
#pragma unroll
        for (int e = 0; e < 4; ++e) y[e] = x[4 * k + e] * rstd * gg[e] + bb[e];
        *(LAS f32x4*)(vln + i * VP + cq * 32 + 4 * k) = y; }
    __syncthreads();
    float acc[32];
#pragma unroll
    for (int c = 0; c < 32; ++c) acc[c] = 0.f;
    const int jmax = (i < 64) ? 64 : 128;
    const float* wrow = w_s + ((size_t)g * 128 + i) * 128;
    for (int j0 = 0; j0 < jmax; j0 += 4) { const f32x4 wv = *(const f32x4*)(wrow + j0);
#pragma unroll
        for (int jj = 0; jj < 4; ++jj)
#pragma unroll
            for (int k = 0; k < 8; ++k) { const f32x4 vv = *(const LAS f32x4*)(vln + (j0 + jj) * VP + cq * 32 + 4 * k);
#pragma unroll
                for (int e = 0; e < 4; ++e) acc[4 * k + e] += wv[jj] * vv[e]; } }
    const float bias = b_s[g * 128 + i];
    float ss = 0.f;
    { const v4u* up = (const v4u*)(zA + (size_t)t * 1024 + cb);
#pragma unroll
      for (int k = 0; k < 4; ++k) { const v4u w = up[k]; float u8[8] = {blo(w.x), bhi(w.x), blo(w.y), bhi(w.y), blo(w.z), bhi(w.z), blo(w.w), bhi(w.w)};
#pragma unroll
          for (int e = 0; e < 8; ++e) { const float o = u8[e] * (acc[8 * k + e] + bias); acc[8 * k + e] = o; ss += o * o; } } }
    ss += __shfl_xor(ss, 1); ss += __shfl_xor(ss, 2);
    const float rr = 1.0f / sqrtf(ss * (1.0f / 128.0f) + EPS);
    { v4u* op = (v4u*)(mix + (size_t)t * 1024 + cb);
#pragma unroll
      for (int k = 0; k < 4; ++k) { const f32x4 b0 = *(const f32x4*)(beta + cb + 8 * k), b1 = *(const f32x4*)(beta + cb + 8 * k + 4); v4u w;
          w.x = pk2(acc[8 * k + 0] * rr * b0[0], acc[8 * k + 1] * rr * b0[1]); w.y = pk2(acc[8 * k + 2] * rr * b0[2], acc[8 * k + 3] * rr * b0[3]);
          w.z = pk2(acc[8 * k + 4] * rr * b1[0], acc[8 * k + 5] * rr * b1[1]); w.w = pk2(acc[8 * k + 6] * rr * b1[2], acc[8 * k + 7] * rr * b1[3]); op[k] = w; } }
    __syncthreads();
}

__device__ __forceinline__ void attn_naive_unit(LAS unsigned char* lds, int b, int h, int qc, const bf16* qb, const bf16* kb, const bf16* vb, const float* rel_bias, float lam, const float* subln_g, bf16* mix, int tid) {
    LAS float* Kt = (LAS float*)lds;
    LAS float* Vt = Kt + 64 * 128;
    LAS float* bt = Vt + 64 * 128;
    const int qi = tid >> 3, comp = (tid >> 2) & 1, part = tid & 3;
    const int tq = b * SEQ + qc * 64 + qi;
    __syncthreads();
    if (tid < 256) bt[tid] = rel_bias[t5_bucket(tid - 192) * 4 + h];
    const float bfar = rel_bias[15 * 4 + h];
    float q[16];
    { const v4u* qp = (const v4u*)(qb + (size_t)tq * 512 + h * 128 + comp * 64 + part * 16);
#pragma unroll
      for (int k = 0; k < 2; ++k) { const v4u w = qp[k]; q[8 * k + 0] = blo(w.x); q[8 * k + 1] = bhi(w.x); q[8 * k + 2] = blo(w.y); q[8 * k + 3] = bhi(w.y); q[8 * k + 4] = blo(w.z); q[8 * k + 5] = bhi(w.z); q[8 * k + 6] = blo(w.w); q[8 * k + 7] = bhi(w.w); } }
    float O[32];
#pragma unroll
    for (int c = 0; c < 32; ++c) O[c] = 0.f;
    float m = -1e30f, l = 0.f;
    for (int kc = 0; kc <= qc; ++kc) {
        __syncthreads();
#pragma unroll
        for (int r = 0; r < 2; ++r) { const int ch = tid + 512 * r, row = ch >> 4, c8 = (ch & 15) * 8; const size_t tk = (size_t)(b * SEQ + kc * 64 + row) * 512 + h * 128 + c8;
            const v4u wk = *(const v4u*)(kb + tk), wv = *(const v4u*)(vb + tk);
            *(LAS f32x4*)(Kt + row * 128 + c8) = (f32x4){blo(wk.x), bhi(wk.x), blo(wk.y), bhi(wk.y)}; *(LAS f32x4*)(Kt + row * 128 + c8 + 4) = (f32x4){blo(wk.z), bhi(wk.z), blo(wk.w), bhi(wk.w)};
            *(LAS f32x4*)(Vt + row * 128 + c8) = (f32x4){blo(wv.x), bhi(wv.x), blo(wv.y), bhi(wv.y)}; *(LAS f32x4*)(Vt + row * 128 + c8 + 4) = (f32x4){blo(wv.z), bhi(wv.z), blo(wv.w), bhi(wv.w)}; }
        __syncthreads();
        const bool farTile = (qc - kc) >= 3;
        const int relbase = (kc - qc) * 64 - qi + 192;
        for (int jg = 0; jg < 8; ++jg) {
            float lg[8];
#pragma unroll
            for (int jj = 0; jj < 8; ++jj) { const int j = jg * 8 + jj; const LAS f32x4* kp = (const LAS f32x4*)(Kt + j * 128 + comp * 64 + part * 16);
                float sdot = 0.f;
#pragma unroll
                for (int k = 0; k < 4; ++k) { const f32x4 kv = kp[k]; sdot += (q[4 * k] * kv[0] + q[4 * k + 1] * kv[1]) + (q[4 * k + 2] * kv[2] + q[4 * k + 3] * kv[3]); }
                sdot += __shfl_xor(sdot, 1); sdot += __shfl_xor(sdot, 2);
                const float bias = farTile ? bfar : bt[relbase + j];
                lg[jj] = sdot + bias; }
            float mx = lg[0];
#pragma unroll
            for (int jj = 1; jj < 8; ++jj) mx = fmaxf(mx, lg[jj]);
            const float mn = fmaxf(m, mx), alpha = __expf(m - mn);
            l *= alpha; m = mn;
#pragma unroll
            for (int c = 0; c < 32; ++c) O[c] *= alpha;
#pragma unroll
            for (int jj = 0; jj < 8; ++jj) { const int j = jg * 8 + jj; const float p = __expf(lg[jj] - m); l += p; const LAS f32x4* vp = (const LAS f32x4*)(Vt + j * 128 + part * 32);
#pragma unroll
                for (int k = 0; k < 8; ++k) { const f32x4 vv = vp[k];
#pragma unroll
                    for (int e = 0; e < 4; ++e) O[4 * k + e] += p * vv[e]; } }
        }
    }
    const float inv = 1.0f / l; float ss = 0.f;
#pragma unroll
    for (int c = 0; c < 32; ++c) { const float o = O[c] * inv; const float other = __shfl_xor(o, 4); const float r = o - lam * other; O[c] = r; ss += r * r; }
    ss += __shfl_xor(ss, 1); ss += __shfl_xor(ss, 2);
    const float rr = 0.8f / sqrtf(ss * (1.0f / 128.0f) + EPS);
    if (comp == 0) { v4u* op = (v4u*)(mix + (size_t)tq * 1024 + 512 + h * 128 + part * 32);
#pragma unroll
        for (int k = 0; k < 4; ++k) { const f32x4 g0 = *(const f32x4*)(subln_g + part * 32 + 8 * k), g1 = *(const f32x4*)(subln_g + part * 32 + 8 * k + 4); v4u w;
            w.x = pk2(O[8 * k + 0] * rr * g0[0], O[8 * k + 1] * rr * g0[1]); w.y = pk2(O[8 * k + 2] * rr * g0[2], O[8 * k + 3] * rr * g0[3]);
            w.z = pk2(O[8 * k + 4] * rr * g1[0], O[8 * k + 5] * rr * g1[1]); w.w = pk2(O[8 * k + 6] * rr * g1[2], O[8 * k + 7] * rr * g1[3]); op[k] = w; } }
}

__device__ __forceinline__ void wave_argmax(float& bv, int& bi) {
#pragma unroll
    for (int off = 32; off >= 1; off >>= 1) { const float ov = __shfl_xor(bv, off); const int oi = __shfl_xor(bi, off); const bool take = (ov > bv) || (ov == bv && oi < bi); bv = take ? ov : bv; bi = take ? oi : bi; }
}
__device__ __forceinline__ float gelu_tanh_f(float x) {
    const float t = x * (1.0f + 0.044715f * x * x) * (-2.3022082f);
    return x * __builtin_amdgcn_rcpf(1.0f + __builtin_amdgcn_exp2f(t));
}
__device__ __forceinline__ void peer_token(LAS unsigned char* wl, int t, int lane, const bf16* pq, const float* part2, const float* keys, const float* u_tab, const float* v_tab, const float* g_ffn, float* hio, bf16* hb, float* rs3) {
    LAS float* qs = (LAS float*)wl; LAS int* sel_e = (LAS int*)(wl + 1024); LAS float* sel_g = (LAS float*)(wl + 1536);
    float ps = lane < 16 ? part2[(size_t)t * 16 + lane] : 0.f; ps = wave_sum(ps);
    const float rs2 = 1.0f / sqrtf(ps * (1.0f / 1024.0f) + EPS);
    const float NEG = -__builtin_inff();
#pragma unroll 1
    for (int h = 0; h < 8; ++h) {
        { const v2u w = *(const v2u*)(pq + (size_t)t * 2048 + h * 256 + 4 * lane);
          *(LAS f32x4*)(qs + 4 * lane) = (f32x4){blo(w.x) * rs2, bhi(w.x) * rs2, blo(w.y) * rs2, bhi(w.y) * rs2}; }
        LDS_WAIT(); asm volatile("" ::: "memory");
        float sv[2]; int si[2];
#pragma unroll
        for (int c = 0; c < 2; ++c) {
            const f32x4* k0 = (const f32x4*)(keys + ((size_t)(h * 2 + c) * 128 + lane) * 128); const f32x4* k1 = k0 + 64 * 32;
            float a0 = 0.f, a1 = 0.f;
#pragma unroll 4
            for (int d4 = 0; d4 < 32; ++d4) { const f32x4 qv = *(const LAS f32x4*)(qs + c * 128 + 4 * d4); a0 += dot4(qv, k0[d4]); a1 += dot4(qv, k1[d4]); }
            float v0 = a0, v1 = a1; float tv = NEG; int ti = 0;
#pragma unroll 1
            for (int it = 0; it < 16; ++it) { float bv = v0 >= v1 ? v0 : v1; int bi = v0 >= v1 ? lane : lane + 64; wave_argmax(bv, bi);
                if (lane == it) { tv = bv; ti = bi; }
                if (bi == lane) v0 = NEG; if (bi == lane + 64) v1 = NEG; }
            sv[c] = tv; si[c] = ti;
        }
        const float a = __shfl(sv[0], lane >> 2);
        float cv[4];
#pragma unroll
        for (int r = 0; r < 4; ++r) cv[r] = a + __shfl(sv[1], (lane & 3) * 4 + r);
        float best = NEG; int bci = 0;
#pragma unroll 1
        for (int it = 0; it < 16; ++it) { float bv = cv[0]; int bi = 4 * lane;
#pragma unroll
            for (int r = 1; r < 4; ++r) if (cv[r] > bv) { bv = cv[r]; bi = 4 * lane + r; }
            wave_argmax(bv, bi);
            if (lane == it) { best = bv; bci = bi; }
#pragma unroll
            for (int r = 0; r < 4; ++r) if (bi == 4 * lane + r) cv[r] = NEG; }
        const int e1 = __shfl(si[0], (bci >> 4) & 15), e2 = __shfl(si[1], bci & 15);
        float mx = best;
#pragma unroll
        for (int off = 8; off >= 1; off >>= 1) mx = fmaxf(mx, __shfl_xor(mx, off));
        const float ex = lane < 16 ? __expf(best - mx) : 0.f; float sum = ex;
#pragma unroll
        for (int off = 8; off >= 1; off >>= 1) sum += __shfl_xor(sum, off);
        if (lane < 16) { sel_e[h * 16 + lane] = e1 * 128 + e2; sel_g[h * 16 + lane] = ex / sum; }
        LDS_WAIT(); asm volatile("" ::: "memory");
    }
    f32x4 hv[4], xn[4], acc[4];
#pragma unroll
    for (int j = 0; j < 4; ++j) { hv[j] = *(const f32x4*)(hio + (size_t)t * 1024 + 256 * j + 4 * lane); const f32x4 gv = *(const f32x4*)(g_ffn + 256 * j + 4 * lane); xn[j] = hv[j] * rs2 * gv; acc[j] = (f32x4){0.f, 0.f, 0.f, 0.f}; }
#pragma unroll 2
    for (int sidx = 0; sidx < 128; ++sidx) {
        const int e = sel_e[sidx]; const float g = sel_g[sidx];
        const f32x4* ur = (const f32x4*)(u_tab + (size_t)e * 1024) + lane; const f32x4* vr = (const f32x4*)(v_tab + (size_t)e * 1024) + lane;
        float d = 0.f;
#pragma unroll
        for (int j = 0; j < 4; ++j) d += dot4(ur[64 * j], xn[j]);
        d = wave_sum(d);
        const float coef = g * gelu_tanh_f(d);
#pragma unroll
        for (int j = 0; j < 4; ++j) acc[j] += coef * vr[64 * j];
    }
    float ss = 0.f;
#pragma unroll
    for (int j = 0; j < 4; ++j) { const f32x4 h2 = hv[j] + acc[j]; *(f32x4*)(hio + (size_t)t * 1024 + 256 * j + 4 * lane) = h2; ss += dot4(h2, h2);
        v2u w; w.x = pk2(h2[0], h2[1]); w.y = pk2(h2[2], h2[3]); *(v2u*)(hb + (size_t)t * 1024 + 256 * j + 4 * lane) = w; }
    ss = wave_sum(ss);
    if (lane == 0) rs3[t] = 1.0f / sqrtf(ss * (1.0f / 1024.0f) + EPS);
}

struct Args { const float* in[25]; float* out; unsigned char* ws; int ph_lo, ph_hi; };

#define AS4 __attribute__((address_space(4)))
#define KARGS_HERE const Args AS4* ap = (const Args AS4*)__builtin_amdgcn_kernarg_segment_ptr(); asm volatile("" : "+s"(ap))
__global__ void __launch_bounds__(NWAVES * 64, 2) fwd(Args args) {
    extern __shared__ __attribute__((aligned(16))) unsigned char lds_raw[];
    LAS unsigned char* lds = (LAS unsigned char*)lds_raw;
    volatile LAS unsigned* MISC = (volatile LAS unsigned*)(lds + MISC_OFF);
    const int tid = threadIdx.x, lane = tid & 63, wave = __builtin_amdgcn_readfirstlane(tid >> 6);
    const int G = gridDim.x, bid = blockIdx.x;
    unsigned char* ws = args.ws;
    if (tid < 32) MISC[tid] = 0u;
    __syncthreads();
    XcdBarrier bar; bar.bar = (unsigned*)(ws + WS_CTL); bar.x = 0; bar.st = nullptr;
    if (N_LAUNCHES == 1) bar = xcd_barrier_post((unsigned*)(ws + WS_CTL), MISC + 8);
#define GRID_BAR() do { if (N_LAUNCHES == 1) xcd_barrier(bar); } while (0)
    const int lo = args.ph_lo, hi = args.ph_hi;
#ifdef ONLY_PHASE
#define IN(k) ((k) == ONLY_PHASE)
#else
#define IN(k) (lo <= (k) && (k) < hi)
#endif
#define IN_X       (ap->in[0])
#define IN_P       (ap->in[1])
#define IN_GMIX    (ap->in[2])
#define IN_WIN     (ap->in[3])
#define IN_LNG     (ap->in[4])
#define IN_LNB     (ap->in[5])
#define IN_WS      (ap->in[6])
#define IN_BS      (ap->in[7])
#define IN_BETA    (ap->in[8])
#define IN_LQ1     (ap->in[9])
#define IN_LK1     (ap->in[10])
#define IN_LQ2     (ap->in[11])
#define IN_LK2     (ap->in[12])
#define IN_SUBLN   (ap->in[13])
#define IN_RELB    (ap->in[14])
#define IN_WOUT    (ap->in[15])
#define IN_GFFN    (ap->in[16])
#define IN_WQ      (ap->in[17])
#define IN_KEYS    (ap->in[18])
#define IN_UTAB    (ap->in[19])
#define IN_VTAB    (ap->in[20])
#define IN_GPLE    (ap->in[21])
#define IN_WPLE    (ap->in[22])
#define IN_WGATE   (ap->in[23])
#define IN_GFINAL  (ap->in[24])
#define OUTP       (ap->out)
#define Win_t   ((bf16*)(ws + WS_WIN))
#define Wout_t  ((bf16*)(ws + WS_WOUT))
#define Wq_t    ((bf16*)(ws + WS_WQ))
#define Wgate_t ((bf16*)(ws + WS_WGATE))
#define Wple_t  ((bf16*)(ws + WS_WPLE))
#define rs1     ((float*)(ws + WS_RS1))
#define rs3     ((float*)(ws + WS_RS3))
#define part4   ((float*)(ws + WS_PART4))
#define part2   ((float*)(ws + WS_PART2))
#define Abuf    ((bf16*)(ws + WS_A))
#define pb      ((bf16*)(ws + WS_PB))
#define pleb    ((bf16*)(ws + WS_PLE))
#define mix     ((bf16*)(ws + WS_M))
#define pq      ((bf16*)(ws + WS_M))
#define vbuf    ((bf16*)(ws + WS_F))
#define zA      ((bf16*)ap->out)
#define qbuf    ((bf16*)((unsigned char*)ap->out + 32 * MiB))
#define kbuf    ((bf16*)((unsigned char*)ap->out + 48 * MiB))
    const int gw = bid * NWAVES + wave, NGW = G * NWAVES;

    if (IN(0)) { KARGS_HERE;
        LAS float* scr = (LAS float*)(lds + wave * 16384);
        constexpr int I_IN = 16 * 80, I_OUT = 16 * 32, I_Q = 16 * 64, I_G = 16 * 32, I_P = 4 * 32;
        for (int it = gw; it < I_IN + I_OUT + I_Q + I_G + I_P; it += NGW) {
            int r = it;
            if (r < I_IN) { p0_transpose_item(IN_WIN, IN_GMIX, 1024, 2560, Win_t, scr, r, lane); continue; } r -= I_IN;
            if (r < I_OUT) { p0_transpose_item(IN_WOUT, nullptr, 1024, 1024, Wout_t, scr, r, lane); continue; } r -= I_OUT;
            if (r < I_Q) { p0_transpose_item(IN_WQ, IN_GFFN, 1024, 2048, Wq_t, scr, r, lane); continue; } r -= I_Q;
            if (r < I_G) { p0_transpose_item(IN_WGATE, IN_GPLE, 1024, 1024, Wgate_t, scr, r, lane); continue; } r -= I_G;
            p0_transpose_item(IN_WPLE, nullptr, 256, 1024, Wple_t, scr, r, lane);
        }
        for (int m = gw; m < T; m += NGW) {
            const f32x4* xr = (const f32x4*)(IN_X + (size_t)m * D) + lane; f32x4 v[4]; float s = 0.f;
#pragma unroll
            for (int j = 0; j < 4; ++j) { v[j] = xr[64 * j]; s += dot4(v[j], v[j]); }
            s = wave_sum(s);
            if (lane == 0) rs1[m] = 1.0f / sqrtf(s * (1.0f / 1024.0f) + EPS);
            v2u* o = (v2u*)(Abuf + (size_t)m * D) + lane;
#pragma unroll
            for (int j = 0; j < 4; ++j) { v2u w; w.x = pk2(v[j][0], v[j][1]); w.y = pk2(v[j][2], v[j][3]); o[64 * j] = w; }
            const f32x4 pv = *((const f32x4*)(IN_P + (size_t)m * 256) + lane); v2u w; w.x = pk2(pv[0], pv[1]); w.y = pk2(pv[2], pv[3]); *((v2u*)(pb + (size_t)m * 256) + lane) = w;
        }
        if (IN(1)) GRID_BAR();
    }
    if (IN(1)) { KARGS_HERE;
        { pg8::Gemm g{Abuf, Win_t, T, 2560, 1024}; pg8::StaticOrder S; S.init(T, 2560, G, bid);
          pg8::EpiZ E{zA, qbuf, kbuf, vbuf, rs1, 0.125f};
          pg8::gemm_phase<pg8::EpiZ, pg8::StaticOrder, true, true>(lds, g, S, E); }
        { pg8::Gemm g{pb, Wple_t, T, 1024, 256}; pg8::StaticOrder S; S.init(T, 1024, G, bid);
          pg8::EpiBf E{pleb, 1024};
          pg8::gemm_phase<pg8::EpiBf, pg8::StaticOrder, true, true>(lds, g, S, E); }
        if (IN(2)) GRID_BAR();
    }
    if (IN(2)) { KARGS_HERE;
        for (int u = bid; u < 512; u += G) gmlp_unit(lds, u >> 2, u & 3, zA, IN_LNG, IN_LNB, IN_WS, IN_BS, IN_BETA, mix, tid);
        float lam;
        { const float a = IN_LQ1[lane] * IN_LK1[lane], b2 = IN_LQ2[lane] * IN_LK2[lane]; lam = __expf(wave_sum(a)) - __expf(wave_sum(b2)) + 0.2f; }
        for (int i = 0; ; ++i) { const int u = i * G + bid; if (u >= 1024) break;
            const int grp = u >> 4, bh = u & 15, i16 = grp >> 4, c16 = grp & 15; const int qc = 63 - 16 * i16 - ((i16 & 1) ? (15 - c16) : c16);
            attn_naive_unit(lds, bh >> 2, bh & 3, qc, qbuf, kbuf, vbuf, IN_RELB, lam, IN_SUBLN, mix, tid); }
        if (IN(3)) GRID_BAR();
    }
    if (IN(3)) { KARGS_HERE;
        pg8::Gemm g{mix, Wout_t, T, 1024, 1024}; pg8::StaticOrder S; S.init(T, 1024, G, bid);
        pg8::EpiRes E{IN_X, OUTP, Abuf, part2};
        pg8::gemm_phase<pg8::EpiRes, pg8::StaticOrder, true, true>(lds, g, S, E);
        if (IN(4)) GRID_BAR();
    }
    if (IN(4)) { KARGS_HERE;
        pg8::Gemm g{Abuf, Wq_t, T, 2048, 1024}; pg8::StaticOrder S; S.init(T, 2048, G, bid);
        pg8::EpiBf E{pq, 2048};
        pg8::gemm_phase<pg8::EpiBf, pg8::StaticOrder, true, true>(lds, g, S, E);
        if (IN(5)) GRID_BAR();
    }
    if (IN(5)) { KARGS_HERE;
        for (int t = gw; t < T; t += NGW) peer_token(lds + wave * 2048, t, lane, pq, part2, IN_KEYS, IN_UTAB, IN_VTAB, IN_GFFN, OUTP, Abuf, rs3);
        if (IN(6)) GRID_BAR();
    }
    if (IN(6)) { KARGS_HERE;
        pg8::Gemm g{Abuf, Wgate_t, T, 1024, 1024}; pg8::StaticOrder S; S.init(T, 1024, G, bid);
        pg8::EpiGate E{OUTP, pleb, rs3, part4};
        pg8::gemm_phase<pg8::EpiGate, pg8::StaticOrder, true, true>(lds, g, S, E);
        if (IN(7)) GRID_BAR();
    }
    if (IN(7)) { KARGS_HERE;
        for (int m = gw; m < T; m += NGW) {
            float ps = lane < 16 ? part4[(size_t)m * 16 + lane] : 0.f; ps = wave_sum(ps);
            const float r = 1.0f / sqrtf(ps * (1.0f / 1024.0f) + EPS);
            f32x4* hr = (f32x4*)(OUTP + (size_t)m * D) + lane;
#pragma unroll
            for (int j = 0; j < 4; ++j) { const f32x4 gv = *((const f32x4*)IN_GFINAL + 64 * j + lane); hr[64 * j] = hr[64 * j] * r * gv; }
        }
    }
#undef IN
#undef GRID_BAR
}

extern "C" void kernel_launch(void* const* d_in, const int* in_sizes, int n_in, void* d_out, int out_size, void* d_ws, size_t ws_size, hipStream_t stream) {
    static int grid = 0;
    if (grid == 0) {
        if (n_in != 25 || out_size != T * D || ws_size < WS_END) { fprintf(stderr, "kernel_launch: unexpected shapes (n_in %d, out %d, ws %zu)\n", n_in, out_size, ws_size); grid = -1; return; }
        int dev = 0, cus = 0, per_cu = 0;
        if (hipGetDevice(&dev) != hipSuccess || hipDeviceGetAttribute(&cus, hipDeviceAttributeMultiprocessorCount, dev) != hipSuccess) { grid = -1; return; }
        if (hipFuncSetAttribute((const void*)fwd, hipFuncAttributeMaxDynamicSharedMemorySize, LDS_BYTES) != hipSuccess) { fprintf(stderr, "kernel_launch: hipFuncSetAttribute failed\n"); grid = -1; return; }
        if (hipOccupancyMaxActiveBlocksPerMultiprocessor(&per_cu, (const void*)fwd, NWAVES * 64, LDS_BYTES) != hipSuccess || per_cu < 1) { fprintf(stderr, "kernel_launch: occupancy query says %d blocks per CU\n", per_cu); }
        (void)hipGetLastError();
        grid = cus;
    }
    if (grid < 0) return;
    if (N_LAUNCHES == 1) (void)hipMemsetAsync((char*)d_ws + WS_CTL, 0, CTL_ZERO_BYTES, stream);
    Args a{};
    for (int i = 0; i < 25; ++i) a.in[i] = (const float*)d_in[i];
    a.out = (float*)d_out; a.ws = (unsigned char*)d_ws;
    if (N_LAUNCHES == 1) { a.ph_lo = 0; a.ph_hi = NPHASE; hipLaunchKernelGGL(fwd, dim3(grid), dim3(NWAVES * 64), LDS_BYTES, stream, a); }
    else for (int li = 0; li < NPHASE; ++li) { a.ph_lo = li; a.ph_hi = li + 1; hipLaunchKernelGGL(fwd, dim3(grid), dim3(NWAVES * 64), LDS_BYTES, stream, a); }
}
```

```cpp
#include <hip/hip_runtime.h>
#include <cstdio>
#include <cstdint>
namespace pg8 {
#define PG8_LAS __attribute__((address_space(3)))
typedef unsigned short bf16_t;
typedef short bf16x8 __attribute__((ext_vector_type(8)));
typedef float f32x4 __attribute__((ext_vector_type(4)));
typedef unsigned u32x4 __attribute__((ext_vector_type(4)));
constexpr int BM = 256, BK = 64, HALF = 128, HTB = HALF * BK * 2  , STAGE_BYTES = 8 * HTB, NXCD = 8, WGM = 8;

__host__ __device__ __forceinline__ int lds_byte(int r, int c) { const int st = (r >> 4) * 2 + (c >> 5), rr = r & 15, cc = c & 31, ob = rr * 64 + cc * 2; return st * 1024 + (ob ^ (((ob >> 9) & 1) << 5)); }
__host__ __device__ __forceinline__ void stage_rc(int b, int& R, int& C) { const int st = b / 1024, sb = b % 1024, swz = sb ^ (((sb >> 9) & 1) << 5); R = (st >> 1) * 16 + swz / 64; C = (st & 1) * 32 + (swz % 64) / 2; }
__host__ __device__ __forceinline__ int perm32(int rho) { const int n = rho >> 4, i = rho & 15; return 8 * (i >> 2) + 4 * n + (i & 3); }

struct Unit { int pm, pn; };
struct Gemm { const bf16_t* A; const bf16_t* Bt; int M, N, K; };

struct StaticOrder {
    int nM, nN, nwg, G, c;
    __host__ __device__ void init(int M, int N, int G_, int c_) { nM = M / BM; nN = N / BM; nwg = nM * nN; G = G_; c = c_; }
    __host__ __device__ bool next(int i, Unit& u) const {
        const long L = (long)i * G + c; if (L >= nwg) return false;
        int wgid = (int)L; { const int q = nwg / NXCD, r = nwg % NXCD, xcd = wgid % NXCD, off = wgid / NXCD; wgid = (xcd < r ? xcd * (q + 1) : r * (q + 1) + (xcd - r) * q) + off; }
        const int nig = WGM * nN, gid = wgid / nig, fm = gid * WGM, gsz = (nM - fm) < WGM ? (nM - fm) : WGM;
        u.pm = fm + ((wgid % nig) % gsz); u.pn = (wgid % nig) / gsz; return true;
    }
    __device__ __forceinline__ void a_ready(const Unit&) const {}
    __device__ __forceinline__ void done(const Unit&) const {}
};


__device__ __forceinline__ unsigned cvt_pk_bf16(float lo, float hi) { unsigned r; asm volatile("v_cvt_pk_bf16_f32 %0, %1, %2" : "=v"(r) : "v"(lo), "v"(hi)); return r; }
typedef unsigned u32x2 __attribute__((ext_vector_type(2)));
__device__ __forceinline__ float gelu_tanh(float x) {
    const float t = x * (1.0f + 0.044715f * x * x) * (-2.3022082f);
    return x * __builtin_amdgcn_rcpf(1.0f + __builtin_amdgcn_exp2f(t));
}
__device__ __forceinline__ float bf_lo(unsigned w) { return __uint_as_float(w << 16); }
__device__ __forceinline__ float bf_hi(unsigned w) { return __uint_as_float(w & 0xffff0000u); }

struct EpiZ {
    static constexpr bool PERM = true, AFTER_DRAIN = false;
    bf16_t *zA, *q, *k, *v; const float* rs; float qscale;
    __device__ __forceinline__ void operator()(const f32x4 (&acc)[2][2][4][2], const Unit& u, int wr, int wc, int fr, int fq) const {
        const int pn = u.pn; bf16_t* base; int ldc, colt; float sc = 1.f; bool act = false;
        if (pn < 4) { base = zA; ldc = 1024; colt = pn * BM; act = true; }
        else if (pn < 6) { base = q; ldc = 512; colt = (pn - 4) * BM; sc = qscale; }
        else if (pn < 8) { base = k; ldc = 512; colt = (pn - 6) * BM; }
        else { base = v; ldc = 512; colt = (pn - 8) * BM; }
        const int row0 = u.pm * BM + wr * 64 + fr, col0 = colt + wc * 32 + 8 * fq;
#pragma unroll
        for (int ai = 0; ai < 2; ++ai)
#pragma unroll
            for (int m = 0; m < 4; ++m) { const int r = row0 + ai * HALF + m * 16; const float s = rs[r] * sc; bf16_t* rowp = base + (size_t)r * ldc + col0;
#pragma unroll
                for (int bj = 0; bj < 2; ++bj) { f32x4 v0 = acc[ai][bj][m][0] * s, v1 = acc[ai][bj][m][1] * s;
                    if (act) {
#pragma unroll
                        for (int j = 0; j < 4; ++j) { v0[j] = gelu_tanh(v0[j]); v1[j] = gelu_tanh(v1[j]); } }
                    u32x4 w; w.x = cvt_pk_bf16(v0[0], v0[1]); w.y = cvt_pk_bf16(v0[2], v0[3]); w.z = cvt_pk_bf16(v1[0], v1[1]); w.w = cvt_pk_bf16(v1[2], v1[3]);
                    *(u32x4*)(rowp + bj * HALF) = w; }
                asm volatile("" ::: "memory"); }
    }
};
struct EpiBf {
    static constexpr bool PERM = true, AFTER_DRAIN = false;
    bf16_t* O; int ldc;
    __device__ __forceinline__ void operator()(const f32x4 (&acc)[2][2][4][2], const Unit& u, int wr, int wc, int fr, int fq) const {
        const int row0 = u.pm * BM + wr * 64 + fr, col0 = u.pn * BM + wc * 32 + 8 * fq;
#pragma unroll
        for (int ai = 0; ai < 2; ++ai)
#pragma unroll
            for (int m = 0; m < 4; ++m) { bf16_t* rowp = O + (size_t)(row0 + ai * HALF + m * 16) * ldc + col0;
#pragma unroll
                for (int bj = 0; bj < 2; ++bj) { const f32x4 v0 = acc[ai][bj][m][0], v1 = acc[ai][bj][m][1];
                    u32x4 w; w.x = cvt_pk_bf16(v0[0], v0[1]); w.y = cvt_pk_bf16(v0[2], v0[3]); w.z = cvt_pk_bf16(v1[0], v1[1]); w.w = cvt_pk_bf16(v1[2], v1[3]);
                    *(u32x4*)(rowp + bj * HALF) = w; } }
    }
};
struct EpiRes {
    static constexpr bool PERM = false, AFTER_DRAIN = false;
    const float* base; float* out; bf16_t* hb; float* part;
    __device__ __forceinline__ void operator()(const f32x4 (&acc)[2][2][4][2], const Unit& u, int wr, int wc, int fr, int fq) const {
        const int row0 = u.pm * BM + wr * 64 + fr, col0 = u.pn * BM + wc * 32 + 4 * fq;
#pragma unroll
        for (int ai = 0; ai < 2; ++ai)
#pragma unroll
            for (int m = 0; m < 4; ++m) { const int r = row0 + ai * HALF + m * 16; const size_t off = (size_t)r * 1024 + col0; float ss = 0.f;
#pragma unroll
                for (int bj = 0; bj < 2; ++bj)
#pragma unroll
                    for (int n = 0; n < 2; ++n) { const size_t o = off + bj * HALF + n * 16; const f32x4 b = *(const f32x4*)(base + o); const f32x4 h = b + acc[ai][bj][m][n];
                        *(f32x4*)(out + o) = h; ss += (h[0] * h[0] + h[1] * h[1]) + (h[2] * h[2] + h[3] * h[3]);
                        u32x2 w; w.x = cvt_pk_bf16(h[0], h[1]); w.y = cvt_pk_bf16(h[2], h[3]); *(u32x2*)(hb + o) = w; }
                ss += __shfl_xor(ss, 16); ss += __shfl_xor(ss, 32);
                if (fq == 0) part[(size_t)r * 16 + u.pn * 4 + wc] = ss; }
    }
};
struct EpiGate {
    static constexpr bool PERM = false, AFTER_DRAIN = false;
    float* hio; const bf16_t* ple; const float* rs; float* part;
    __device__ __forceinline__ void operator()(const f32x4 (&acc)[2][2][4][2], const Unit& u, int wr, int wc, int fr, int fq) const {
        const int row0 = u.pm * BM + wr * 64 + fr, col0 = u.pn * BM + wc * 32 + 4 * fq;
#pragma unroll
        for (int ai = 0; ai < 2; ++ai)
#pragma unroll
            for (int m = 0; m < 4; ++m) { const int r = row0 + ai * HALF + m * 16; const size_t off = (size_t)r * 1024 + col0; float ss = 0.f; const float s = rs[r] * (-1.44269504f);
#pragma unroll
                for (int bj = 0; bj < 2; ++bj)
#pragma unroll
                    for (int n = 0; n < 2; ++n) { const size_t o = off + bj * HALF + n * 16; f32x4 h = *(const f32x4*)(hio + o); const u32x2 pw = *(const u32x2*)(ple + o);
                        const f32x4 a = acc[ai][bj][m][n]; f32x4 g;
#pragma unroll
                        for (int j = 0; j < 4; ++j) g[j] = __builtin_amdgcn_rcpf(1.0f + __builtin_amdgcn_exp2f(a[j] * s));
                        h[0] += bf_lo(pw.x) * g[0]; h[1] += bf_hi(pw.x) * g[1]; h[2] += bf_lo(pw.y) * g[2]; h[3] += bf_hi(pw.y) * g[3];
                        *(f32x4*)(hio + o) = h; ss += (h[0] * h[0] + h[1] * h[1]) + (h[2] * h[2] + h[3] * h[3]); }
                ss += __shfl_xor(ss, 16); ss += __shfl_xor(ss, 32);
                if (fq == 0) part[(size_t)r * 16 + u.pn * 4 + wc] = ss; }
    }
};

template <class Epi, class Sched, bool ALIGN_EPI = false, bool SP2 = false>
__device__ __forceinline__ void gemm_phase(PG8_LAS unsigned char* lds, const Gemm g, const Sched& S, const Epi& E) {
    const int tid = threadIdx.x, wid = __builtin_amdgcn_readfirstlane(tid >> 6), lane = tid & 63, wr = wid >> 2, wc = wid & 3, fr = lane & 15, fq = lane >> 4;
    const int K = g.K, nt = K / BK;
    unsigned voffA[2], voffB[2];
#pragma unroll
    for (int i = 0; i < 2; ++i) { int R, C; stage_rc(tid * 16 + i * 8192, R, C); const int Rb = Epi::PERM ? ((R & ~31) + perm32(R & 31)) : R;
        voffA[i] = (unsigned)(R * K + C) * 2u; voffB[i] = (unsigned)(Rb * K + C) * 2u; }
    const size_t kstep = (size_t)(BK * 2);
    const size_t hstep = (size_t)HALF * K * 2;
    const size_t tstep = 2 * hstep;
    const unsigned ldsw = (unsigned)wid * 1024u;
    const int aoff = lds_byte(wr * 64 + fr, fq * 8), boff = lds_byte(wc * 32 + fr, fq * 8);
#define PG8_SA(b, h) (((b) * 2 + (h)) * HTB)
#define PG8_SB(b, h) ((4 + (b) * 2 + (h)) * HTB)
#define PG8_STAGE(bufoff, gbase, voff) do { _Pragma("unroll") for (int _i = 0; _i < 2; ++_i) \
        __builtin_amdgcn_global_load_lds((const unsigned*)((const char*)(gbase) + (voff)[_i]), (PG8_LAS unsigned*)(lds + (bufoff) + ldsw + _i * 8192), 16, 0, 0); } while (0)
#define PG8_LDA(dst, b, h) do { _Pragma("unroll") for (int m = 0; m < 4; ++m) _Pragma("unroll") for (int k = 0; k < 2; ++k) dst[m][k] = *(const PG8_LAS bf16x8*)(lds + PG8_SA(b, h) + aoff + m * 2048 + k * 1024); } while (0)
#define PG8_LDB(dst, b, h) do { _Pragma("unroll") for (int n = 0; n < 2; ++n) _Pragma("unroll") for (int k = 0; k < 2; ++k) dst[n][k] = *(const PG8_LAS bf16x8*)(lds + PG8_SB(b, h) + boff + n * 2048 + k * 1024); } while (0)
#define PG8_MMA(ai, bj, At, Bt) do { __builtin_amdgcn_s_setprio(1); _Pragma("unroll") for (int m = 0; m < 4; ++m) _Pragma("unroll") for (int n = 0; n < 2; ++n) _Pragma("unroll") for (int k = 0; k < 2; ++k) \
        acc[ai][bj][m][n] = __builtin_amdgcn_mfma_f32_16x16x32_bf16(Bt[n][k], At[m][k], acc[ai][bj][m][n], 0, 0, 0); __builtin_amdgcn_s_setprio(0); } while (0)
#define PG8_WAIT_V(n) asm volatile("s_waitcnt vmcnt(" #n ")" ::: "memory")
#define PG8_WAIT_L(n) asm volatile("s_waitcnt lgkmcnt(" #n ")" ::: "memory")
#define PG8_BAR __builtin_amdgcn_s_barrier()
#define PG8_SCHED __builtin_amdgcn_sched_barrier(0)
    Unit cur, nxt; int ui = 0;
    if (!S.next(0, cur)) return;
    f32x4 acc[2][2][4][2];
#pragma unroll
    for (int a = 0; a < 2; ++a)
#pragma unroll
        for (int b = 0; b < 2; ++b)
#pragma unroll
            for (int m = 0; m < 4; ++m)
#pragma unroll
                for (int n = 0; n < 2; ++n) acc[a][b][m][n] = (f32x4){0.f, 0.f, 0.f, 0.f};
    bf16x8 At[4][2], B0[2][2], B1[2][2];
    const char* cA = (const char*)g.A + (size_t)cur.pm * tstep; const char* cB = (const char*)g.Bt + (size_t)cur.pn * tstep;
    S.a_ready(cur);
    if constexpr (SP2) {
        PG8_STAGE(PG8_SB(0, 0), cB, voffB); PG8_STAGE(PG8_SB(0, 1), cB + hstep, voffB); PG8_STAGE(PG8_SA(0, 0), cA, voffA); PG8_STAGE(PG8_SA(0, 1), cA + hstep, voffA);
        if (wr == 1) PG8_BAR;
        PG8_WAIT_V(2); PG8_BAR;
        PG8_STAGE(PG8_SB(1, 0), cB + kstep, voffB); PG8_STAGE(PG8_SA(1, 0), cA + kstep, voffA); PG8_STAGE(PG8_SB(1, 1), cB + hstep + kstep, voffB);
        PG8_WAIT_V(6); PG8_BAR;
    } else {
        PG8_STAGE(PG8_SB(0, 0), cB, voffB); PG8_STAGE(PG8_SA(0, 0), cA, voffA); PG8_STAGE(PG8_SB(0, 1), cB + hstep, voffB); PG8_STAGE(PG8_SA(0, 1), cA + hstep, voffA);
        if (wr == 1) PG8_BAR;
        PG8_WAIT_V(4); PG8_BAR;
        PG8_STAGE(PG8_SB(1, 0), cB + kstep, voffB); PG8_STAGE(PG8_SA(1, 0), cA + kstep, voffA); PG8_STAGE(PG8_SB(1, 1), cB + hstep + kstep, voffB);
        PG8_WAIT_V(6); PG8_BAR;
    }
    for (;;) {
        const bool has_next = S.next(ui + 1, nxt);
        const char* nA = has_next ? (const char*)g.A + (size_t)nxt.pm * tstep : cA; const char* nB = has_next ? (const char*)g.Bt + (size_t)nxt.pn * tstep : cB;
        for (int t = 0; t < nt; t += 2) {
            const bool last = (t == nt - 2);
            const char* a1 = cA + (size_t)(t + 1) * kstep;
            const char* a2 = last ? nA : cA + (size_t)(t + 2) * kstep; const char* b2 = last ? nB : cB + (size_t)(t + 2) * kstep;
            const char* a3 = a2 + kstep; const char* b3 = b2 + kstep;
            if (last && has_next) S.a_ready(nxt);
            if constexpr (SP2) {
            PG8_LDB(B0, 0, 0); PG8_LDB(B1, 0, 1); PG8_SCHED; PG8_LDA(At, 0, 0); PG8_STAGE(PG8_SA(1, 1), a1 + hstep, voffA);
            PG8_WAIT_V(8); PG8_WAIT_L(0); PG8_BAR; PG8_MMA(0, 0, At, B0); PG8_MMA(0, 1, At, B1); PG8_BAR; PG8_SCHED;
            PG8_LDA(At, 0, 1); PG8_STAGE(PG8_SB(0, 0), b2, voffB); PG8_STAGE(PG8_SB(0, 1), b2 + hstep, voffB); PG8_STAGE(PG8_SA(0, 0), a2, voffA);
            PG8_WAIT_V(8); PG8_WAIT_L(0); PG8_BAR; PG8_MMA(1, 0, At, B0); PG8_MMA(1, 1, At, B1); PG8_BAR; PG8_SCHED;
            PG8_LDB(B0, 1, 0); PG8_LDB(B1, 1, 1); PG8_SCHED; PG8_LDA(At, 1, 0); PG8_STAGE(PG8_SA(0, 1), a2 + hstep, voffA);
            PG8_WAIT_V(8); PG8_WAIT_L(0); PG8_BAR; PG8_MMA(0, 0, At, B0); PG8_MMA(0, 1, At, B1); PG8_BAR; PG8_SCHED;
            PG8_LDA(At, 1, 1); PG8_STAGE(PG8_SB(1, 0), b3, voffB); PG8_STAGE(PG8_SB(1, 1), b3 + hstep, voffB); PG8_STAGE(PG8_SA(1, 0), a3, voffA);
            PG8_WAIT_V(8); PG8_WAIT_L(0); PG8_BAR; PG8_MMA(1, 0, At, B0); PG8_MMA(1, 1, At, B1); PG8_BAR; PG8_SCHED;
            } else {
            PG8_LDB(B0, 0, 0); PG8_SCHED; PG8_LDA(At, 0, 0); PG8_STAGE(PG8_SA(1, 1), a1 + hstep, voffA);
            PG8_WAIT_L(8); PG8_BAR; PG8_WAIT_L(0); PG8_MMA(0, 0, At, B0); PG8_BAR; PG8_SCHED;
            PG8_LDB(B1, 0, 1); PG8_STAGE(PG8_SB(0, 0), b2, voffB);
            PG8_BAR; PG8_WAIT_L(0); PG8_MMA(0, 1, At, B1); PG8_BAR;
            PG8_LDA(At, 0, 1); PG8_STAGE(PG8_SA(0, 0), a2, voffA);
            PG8_BAR; PG8_WAIT_L(0); PG8_MMA(1, 0, At, B0); PG8_BAR; PG8_SCHED;
            PG8_STAGE(PG8_SB(0, 1), b2 + hstep, voffB);
            PG8_WAIT_V(6); PG8_BAR; PG8_MMA(1, 1, At, B1); PG8_BAR;
            PG8_LDB(B0, 1, 0); PG8_SCHED; PG8_LDA(At, 1, 0); PG8_STAGE(PG8_SA(0, 1), a2 + hstep, voffA);
            PG8_WAIT_L(8); PG8_BAR; PG8_WAIT_L(0); PG8_MMA(0, 0, At, B0); PG8_BAR; PG8_SCHED;
            PG8_LDB(B1, 1, 1); PG8_STAGE(PG8_SB(1, 0), b3, voffB);
            PG8_BAR; PG8_WAIT_L(0); PG8_MMA(0, 1, At, B1); PG8_BAR;
            PG8_LDA(At, 1, 1); PG8_STAGE(PG8_SA(1, 0), a3, voffA);
            PG8_BAR; PG8_WAIT_L(0); PG8_MMA(1, 0, At, B0); PG8_BAR; PG8_SCHED;
            PG8_STAGE(PG8_SB(1, 1), b3 + hstep, voffB);
            PG8_WAIT_V(6); PG8_BAR; PG8_MMA(1, 1, At, B1); PG8_BAR;
            }
        }
        if constexpr (ALIGN_EPI) { if (wr == 0) PG8_BAR; }
        if constexpr (!Epi::AFTER_DRAIN) { E(acc, cur, wr, wc, fr, fq); S.done(cur); }
        if (!has_next) break;
#pragma unroll
        for (int a = 0; a < 2; ++a)
#pragma unroll
            for (int b = 0; b < 2; ++b)
#pragma unroll
                for (int m = 0; m < 4; ++m)
#pragma unroll
                    for (int n = 0; n < 2; ++n) acc[a][b][m][n] = (f32x4){0.f, 0.f, 0.f, 0.f};
        cur = nxt; cA = nA; cB = nB; ++ui;
        if constexpr (ALIGN_EPI) { if (wr == 1) PG8_BAR; }
    }
    PG8_WAIT_V(0);
    if constexpr (!ALIGN_EPI) { if (wr == 0) PG8_BAR; }
    PG8_BAR;
    if constexpr (Epi::AFTER_DRAIN) { E.fused(acc, cur, wr, wc, fr, fq, lds, wid, lane); S.done(cur); }
#undef PG8_SA
#undef PG8_SB
#undef PG8_STAGE
#undef PG8_LDA
#undef PG8_LDB
#undef PG8_MMA
#undef PG8_WAIT_V
#undef PG8_WAIT_L
#undef PG8_BAR
#undef PG8_SCHED
}
}

constexpr int NWAVES = 8;
#ifndef MK_N_LAUNCHES
#define MK_N_LAUNCHES 1
#endif
constexpr int NPHASE = 8;
constexpr int N_LAUNCHES = MK_N_LAUNCHES;

constexpr int T = 16384, D = 1024, SEQ = 4096;
constexpr float EPS = 1e-6f;
constexpr size_t MiB = 1u << 20;
constexpr size_t WS_CTL = 0, CTL_ZERO_BYTES = 16384;
constexpr size_t WS_WIN = 1 * MiB, WS_WOUT = 6 * MiB, WS_WQ = 8 * MiB, WS_WGATE = 12 * MiB, WS_WPLE = 14 * MiB;
constexpr size_t WS_RS1 = 14 * MiB + 512 * 1024, WS_RS3 = WS_RS1 + 65536, WS_PART4 = 15 * MiB, WS_PART2 = 16 * MiB;
constexpr size_t WS_A = 17 * MiB;
constexpr size_t WS_PB = 49 * MiB;
constexpr size_t WS_PLE = 57 * MiB;
constexpr size_t WS_TAB = 89 * MiB;
constexpr size_t WS_SEL = 153 * MiB;
constexpr size_t WS_M = 169 * MiB;
constexpr size_t WS_F = 201 * MiB;
constexpr size_t WS_END = 256 * MiB;
constexpr int RING_BYTES = 131072, MISC_OFF = RING_BYTES + 320, LDS_BYTES = 147456;

#define GAS __attribute__((address_space(1)))
#define LAS __attribute__((address_space(3)))
typedef unsigned short bf16;
typedef unsigned v4u __attribute__((ext_vector_type(4)));
typedef unsigned v2u __attribute__((ext_vector_type(2)));
typedef float f32x4 __attribute__((ext_vector_type(4)));
#define LDS_WAIT() asm volatile("s_waitcnt lgkmcnt(0)" ::: "memory")
__device__ __forceinline__ unsigned f2bf(float f) { unsigned u = __builtin_bit_cast(unsigned, f); return (u + 0x7fffu + ((u >> 16) & 1u)) >> 16; }
__device__ __forceinline__ unsigned pk2(float lo, float hi) { return f2bf(lo) | (f2bf(hi) << 16); }
__device__ __forceinline__ float blo(unsigned w) { return __uint_as_float(w << 16); }
__device__ __forceinline__ float bhi(unsigned w) { return __uint_as_float(w & 0xffff0000u); }
__device__ __forceinline__ float wave_sum(float v) {
#pragma unroll
    for (int o = 1; o < 64; o <<= 1) v += __shfl_xor(v, o);
    return v;
}
__device__ __forceinline__ float dot4(f32x4 a, f32x4 b) { return (a[0] * b[0] + a[1] * b[1]) + (a[2] * b[2] + a[3] * b[3]); }

#define XB_TMO      128
#define XB_XCNT(j)  (256  + 64 * (j))
#define XB_XSUB(j)  (1280 + 64 * (j))
#define XB_XGEN(j)  (2304 + 64 * (j))
#define XB_TOP      3328
#define XB_TOPGEN   3392
#define XCD_BAR_WORDS 3456
#define XB_SPIN_CAP (1u << 18)

__device__ __forceinline__ unsigned xb_ld(unsigned* p)              { return __hip_atomic_load(p, __ATOMIC_RELAXED, __HIP_MEMORY_SCOPE_AGENT); }
__device__ __forceinline__ unsigned xb_add(unsigned* p, unsigned v) { return __hip_atomic_fetch_add(p, v, __ATOMIC_RELAXED, __HIP_MEMORY_SCOPE_AGENT); }
__device__ __forceinline__ unsigned xb_xcc_id() { return (unsigned)__builtin_amdgcn_s_getreg((3 << 11) | 20) & 0xFu; }
#define XB_SPIN(cond, bar) do { unsigned _sp = 0; while (cond) { __builtin_amdgcn_s_sleep(1); \
    if ((++_sp & 255u) == 0u) { if (xb_ld(&(bar)[XB_TMO])) break; if (_sp > XB_SPIN_CAP) { atomicAdd(&(bar)[XB_TMO], 1u); break; } } } } while (0)

struct XcdBarrier {
    unsigned* bar; unsigned x;
    volatile LAS unsigned* st;
};

__device__ __forceinline__ XcdBarrier xcd_barrier_post(unsigned* bar, volatile LAS unsigned* st) {
    XcdBarrier b; b.bar = bar; b.x = xb_xcc_id(); b.st = st;
    if (threadIdx.x == 0) (void)xb_add(&bar[XB_XCNT(b.x)], 1u);
    return b;
}
__device__ __forceinline__ void xcd_barrier_complete(unsigned* bar, unsigned x, unsigned& nloc, unsigned& nx) {
    const unsigned G = gridDim.x * gridDim.y * gridDim.z;
    unsigned sum, cnt, mine, sp = 0u;
    for (;;) {
        sum = 0u; cnt = 0u; mine = 0u;
#pragma unroll
        for (unsigned j = 0; j < 16; ++j) { const unsigned c = xb_ld(&bar[XB_XCNT(j)]); sum += c; cnt += (c > 0u) ? 1u : 0u; mine = (j == x) ? c : mine; }
        if (sum == G) break;
        __builtin_amdgcn_s_sleep(1);
        if ((++sp & 255u) == 0u) { if (xb_ld(&bar[XB_TMO])) break; if (sp > XB_SPIN_CAP) { atomicAdd(&bar[XB_TMO], 1u); break; } }
    }
    nloc = mine > 0u ? mine : 1u; nx = cnt > 0u ? cnt : 1u;
}

__device__ __forceinline__ void xcd_barrier(const XcdBarrier& b) {
    asm volatile("s_waitcnt vmcnt(0)" ::: "memory");
    __syncthreads();
    if (threadIdx.x == 0) {
        unsigned* bar = b.bar;
        __builtin_amdgcn_s_waitcnt(0);
        unsigned nloc = b.st[0], nx = b.st[1];
        if (nloc == 0u) { xcd_barrier_complete(bar, b.x, nloc, nx); b.st[0] = nloc; b.st[1] = nx; }
        const unsigned old = xb_add(&bar[XB_XSUB(b.x)], 1u);
        const unsigned gen = old / nloc;
        if (old + 1u == (gen + 1u) * nloc) {
            __builtin_amdgcn_fence(__ATOMIC_RELEASE, "agent");
            asm volatile("s_waitcnt vmcnt(0)" ::: "memory");
            const unsigned og = xb_add(&bar[XB_TOP], 1u);
            const unsigned tg = og / nx;
            if (og + 1u == (tg + 1u) * nx) xb_add(&bar[XB_TOPGEN], 1u);
            else XB_SPIN(xb_ld(&bar[XB_TOPGEN]) == tg, bar);
            __builtin_amdgcn_fence(__ATOMIC_ACQUIRE, "agent");
            xb_add(&bar[XB_XGEN(b.x)], 1u);
            asm volatile("s_waitcnt vmcnt(0)" ::: "memory");
        } else {
            XB_SPIN(xb_ld(&bar[XB_XGEN(b.x)]) == gen, bar);
            __builtin_amdgcn_fence(__ATOMIC_ACQUIRE, "agent");
            asm volatile("s_waitcnt vmcnt(0)" ::: "memory");
        }
    }
    __syncthreads();
}

__device__ __forceinline__ void p0_transpose_item(const float* W, const float* gain, int K, int N, bf16* WT, LAS float* scr, int item, int lane) {
    const int nblk = N / 32, kb = item / nblk, nb = item % nblk, k0 = 64 * kb, n0 = 32 * nb;
#pragma unroll 8
    for (int i = 0; i < 32; ++i) { const int kk = 2 * i + (lane >> 5); const float g = gain ? gain[k0 + kk] : 1.0f; scr[kk * 33 + (lane & 31)] = W[(size_t)(k0 + kk) * N + n0 + (lane & 31)] * g; }
    LDS_WAIT(); asm volatile("" ::: "memory");
    const int c = lane & 7;
#pragma unroll
    for (int j = 0; j < 4; ++j) { const int n = (lane >> 3) + 8 * j; const LAS float* s = scr + (8 * c) * 33 + n;
        v4u o; o.x = pk2(s[0 * 33], s[1 * 33]); o.y = pk2(s[2 * 33], s[3 * 33]); o.z = pk2(s[4 * 33], s[5 * 33]); o.w = pk2(s[6 * 33], s[7 * 33]);
        *(v4u*)(WT + (size_t)(n0 + n) * K + k0 + 8 * c) = o; }
    LDS_WAIT(); asm volatile("" ::: "memory");
}

__device__ __forceinline__ int t5_bucket(int rel) {
    const int n = rel < 0 ? -rel : rel;
    const int large = 8 + (n >= 12) + (n >= 16) + (n >= 23) + (n >= 32) + (n >= 46) + (n >= 64) + (n >= 91);
    return (rel > 0 ? 16 : 0) + (n < 8 ? n : large);
}

__device__ __forceinline__ void gmlp_unit(LAS unsigned char* lds, int nb, int g, const bf16* zA, const float* ln_g, const float* ln_b, const float* w_s, const float* b_s, const float* beta, bf16* mix, int tid) {
    constexpr int VP = 132;
    LAS float* vln = (LAS float*)lds;
    const int i = tid >> 2, cq = tid & 3, t = nb * 128 + i, cb = g * 128 + cq * 32;
    float x[32];
    { const v4u* vp = (const v4u*)(zA + (size_t)t * 1024 + 512 + cb);
#pragma unroll
      for (int k = 0; k < 4; ++k) { const v4u w = vp[k]; x[8 * k + 0] = blo(w.x); x[8 * k + 1] = bhi(w.x); x[8 * k + 2] = blo(w.y); x[8 * k + 3] = bhi(w.y); x[8 * k + 4] = blo(w.z); x[8 * k + 5] = bhi(w.z); x[8 * k + 6] = blo(w.w); x[8 * k + 7] = bhi(w.w); } }
    float s = 0.f;
#pragma unroll
    for (int c = 0; c < 32; ++c) s += x[c];
    s += __shfl_xor(s, 1); s += __shfl_xor(s, 2);
    const float mean = s * (1.0f / 128.0f); float q = 0.f;
#pragma unroll
    for (int c = 0; c < 32; ++c) { x[c] -= mean; q += x[c] * x[c]; }
    q += __shfl_xor(q, 1); q += __shfl_xor(q, 2);
    const float rstd = 1.0f / sqrtf(q * (1.0f / 128.0f) + EPS);
#pragma unroll
    for (int k = 0; k < 8; ++k) { const f32x4 gg = *(const f32x4*)(ln_g + cb + 4 * k), bb = *(const f32x4*)(ln_b + cb + 4 * k); f32x4 y;
#pragma unroll
        for (int e = 0; e < 4; ++e) y[e] = x[4 * k + e] * rstd * gg[e] + bb[e];
        *(LAS f32x4*)(vln + i * VP + cq * 32 + 4 * k) = y; }
    __syncthreads();
    float acc[32];
#pragma unroll
    for (int c = 0; c < 32; ++c) acc[c] = 0.f;
    const int jmax = (i < 64) ? 64 : 128;
    const float* wrow = w_s + ((size_t)g * 128 + i) * 128;
    for (int j0 = 0; j0 < jmax; j0 += 4) { const f32x4 wv = *(const f32x4*)(wrow + j0);
#pragma unroll
        for (int jj = 0; jj < 4; ++jj)
#pragma unroll
            for (int k = 0; k < 8; ++k) { const f32x4 vv = *(const LAS f32x4*)(vln + (j0 + jj) * VP + cq * 32 + 4 * k);
#pragma unroll
                for (int e = 0; e < 4; ++e) acc[4 * k + e] += wv[jj] * vv[e]; } }
    const float bias = b_s[g * 128 + i];
    float ss = 0.f;
    { const v4u* up = (const v4u*)(zA + (size_t)t * 1024 + cb);
#pragma unroll
      for (int k = 0; k < 4; ++k) { const v4u w = up[k]; float u8[8] = {blo(w.x), bhi(w.x), blo(w.y), bhi(w.y), blo(w.z), bhi(w.z), blo(w.w), bhi(w.w)};
#pragma unroll
          for (int e = 0; e < 8; ++e) { const float o = u8[e] * (acc[8 * k + e] + bias); acc[8 * k + e] = o; ss += o * o; } } }
    ss += __shfl_xor(ss, 1); ss += __shfl_xor(ss, 2);
    const float rr = 1.0f / sqrtf(ss * (1.0f / 128.0f) + EPS);
    { v4u* op = (v4u*)(mix + (size_t)t * 1024 + cb);
#pragma unroll
      for (int k = 0; k < 4; ++k) { const f32x4 b0 = *(const f32x4*)(beta + cb + 8 * k), b1 = *(const f32x4*)(beta + cb + 8 * k + 4); v4u w;
          w.x = pk2(acc[8 * k + 0] * rr * b0[0], acc[8 * k + 1] * rr * b0[1]); w.y = pk2(acc[8 * k + 2] * rr * b0[2], acc[8 * k + 3] * rr * b0[3]);
          w.z = pk2(acc[8 * k + 4] * rr * b1[0], acc[8 * k + 5] * rr * b1[1]); w.w = pk2(acc[8 * k + 6] * rr * b1[2], acc[8 * k + 7] * rr * b1[3]); op[k] = w; } }
    __syncthreads();
}

typedef short bf16x8_t __attribute__((ext_vector_type(8)));
typedef short s16x4_t __attribute__((ext_vector_type(4)));
typedef float f32x16 __attribute__((ext_vector_type(16)));
typedef __bf16 bf2_t __attribute__((ext_vector_type(2)));
typedef float f2_t __attribute__((ext_vector_type(2)));
__device__ __forceinline__ unsigned cvt2bf(float a, float b) { const f2_t v = {a, b}; const bf2_t r = __builtin_convertvector(v, bf2_t); return __builtin_bit_cast(unsigned, r); }
template <int OFF> __device__ __forceinline__ s16x4_t tr_read(unsigned addr) { s16x4_t r; asm volatile("ds_read_b64_tr_b16 %0, %1 offset:%2" : "=&v"(r) : "v"(addr), "i"(OFF) : "memory"); return r; }
constexpr int AT_KP = 272, AT_VP = 320, AT_KBUF = 64 * AT_KP, AT_VBUF = 64 * AT_VP, AT_OFF_V = 2 * AT_KBUF, AT_OFF_BT = AT_OFF_V + 2 * AT_VBUF;
static_assert(AT_OFF_BT + 1024 <= RING_BYTES, "attention LDS map");
template <int DB> __device__ __forceinline__ void attn_pv(f32x16& o, unsigned va, const bf16x8_t (&pf)[2][2]) {
    const s16x4_t l00 = tr_read<0 * 32 * AT_VP + 0 * 16 * AT_VP + DB * 64>(va), h00 = tr_read<0 * 32 * AT_VP + 0 * 16 * AT_VP + 8 * AT_VP + DB * 64>(va);
    const s16x4_t l01 = tr_read<0 * 32 * AT_VP + 1 * 16 * AT_VP + DB * 64>(va), h01 = tr_read<0 * 32 * AT_VP + 1 * 16 * AT_VP + 8 * AT_VP + DB * 64>(va);
    const s16x4_t l10 = tr_read<1 * 32 * AT_VP + 0 * 16 * AT_VP + DB * 64>(va), h10 = tr_read<1 * 32 * AT_VP + 0 * 16 * AT_VP + 8 * AT_VP + DB * 64>(va);
    const s16x4_t l11 = tr_read<1 * 32 * AT_VP + 1 * 16 * AT_VP + DB * 64>(va), h11 = tr_read<1 * 32 * AT_VP + 1 * 16 * AT_VP + 8 * AT_VP + DB * 64>(va);
    asm volatile("s_waitcnt lgkmcnt(0)" ::: "memory"); __builtin_amdgcn_sched_barrier(0);
#define AT_PK(L, H) (bf16x8_t){L[0], L[1], L[2], L[3], H[0], H[1], H[2], H[3]}
    o = __builtin_amdgcn_mfma_f32_32x32x16_bf16(AT_PK(l00, h00), pf[0][0], o, 0, 0, 0);
    o = __builtin_amdgcn_mfma_f32_32x32x16_bf16(AT_PK(l01, h01), pf[0][1], o, 0, 0, 0);
    o = __builtin_amdgcn_mfma_f32_32x32x16_bf16(AT_PK(l10, h10), pf[1][0], o, 0, 0, 0);
    o = __builtin_amdgcn_mfma_f32_32x32x16_bf16(AT_PK(l11, h11), pf[1][1], o, 0, 0, 0);
#undef AT_PK
}
__device__ __forceinline__ void attn_unit(LAS unsigned char* lds, int b, int h, int jb, const bf16* qb, const bf16* kb, const bf16* vb, const float* rel_bias, float lam, const float* subln_g, bf16* mix, int tid, int lane, int wave) {
    const int comp = wave >> 2, qsub = wave & 3, r = lane & 31, hh = lane >> 5;
    const int cq = 2 * jb + (qsub >> 1), nt = 2 * jb + 2;
    const int qpos = 128 * jb + 32 * qsub + r;
    const size_t tq = (size_t)b * SEQ + qpos;
    LAS float* bt = (LAS float*)(lds + AT_OFF_BT);
    __syncthreads();
    if (tid < 256) bt[tid] = (rel_bias[t5_bucket(tid - 192) * 4 + h] - rel_bias[15 * 4 + h]) * 1.44269504f;
    bf16x8_t qf[4];
#pragma unroll
    for (int ks = 0; ks < 4; ++ks) qf[ks] = *(const bf16x8_t*)(qb + tq * 512 + h * 128 + comp * 64 + 16 * ks + 8 * hh);
    f32x16 oacc[4];
#pragma unroll
    for (int db = 0; db < 4; ++db)
#pragma unroll
        for (int i = 0; i < 16; ++i) oacc[db][i] = 0.f;
    float m = -1e30f, l = 0.f;
    const int srow = tid >> 4, sc16 = tid & 15;
    const size_t gsrc = ((size_t)b * SEQ + srow) * 512 + h * 128 + sc16 * 8;
    v4u kreg[2], vreg[2];
#define AT_LOAD(t) do { _Pragma("unroll") for (int c_ = 0; c_ < 2; ++c_) { const size_t o_ = gsrc + ((size_t)(t) * 64 + 32 * c_) * 512; kreg[c_] = *(const v4u*)(kb + o_); vreg[c_] = *(const v4u*)(vb + o_); } } while (0)
#define AT_WRITE(buf) do { _Pragma("unroll") for (int c_ = 0; c_ < 2; ++c_) { *(LAS v4u*)(lds + (buf) * AT_KBUF + (srow + 32 * c_) * AT_KP + sc16 * 16) = kreg[c_]; \
        *(LAS v4u*)(lds + AT_OFF_V + (buf) * AT_VBUF + (srow + 32 * c_) * AT_VP + sc16 * 16) = vreg[c_]; } } while (0)
    AT_LOAD(0); AT_WRITE(0);
    __syncthreads();
    const int i16 = lane & 15, q4 = i16 >> 2, p4 = i16 & 3, blk = (lane >> 4) & 1;
    const unsigned vrd = (unsigned)(size_t)(lds + AT_OFF_V) + (unsigned)((4 * hh + q4) * AT_VP + 32 * blk + 8 * p4);
    for (int t = 0; t < nt; ++t) {
        const int cur = t & 1;
        if (t + 1 < nt) AT_LOAD(t + 1);
        if (t <= cq) {
            const LAS unsigned char* Kb = lds + cur * AT_KBUF + r * AT_KP + comp * 128 + 16 * hh;
            f32x16 s0, s1;
#pragma unroll
            for (int i = 0; i < 16; ++i) { s0[i] = 0.f; s1[i] = 0.f; }
#pragma unroll
            for (int ks = 0; ks < 4; ++ks) { const bf16x8_t a0 = *(const LAS bf16x8_t*)(Kb + 32 * ks), a1 = *(const LAS bf16x8_t*)(Kb + 32 * AT_KP + 32 * ks);
                s0 = __builtin_amdgcn_mfma_f32_32x32x16_bf16(a0, qf[ks], s0, 0, 0, 0); s1 = __builtin_amdgcn_mfma_f32_32x32x16_bf16(a1, qf[ks], s1, 0, 0, 0); }
            if (cq - t <= 2) {
                const LAS float* bp = bt + (t * 64 - qpos + 192 + 4 * hh);
#pragma unroll
                for (int i = 0; i < 16; ++i) { s0[i] += bp[(i & 3) + 8 * (i >> 2)]; s1[i] += bp[32 + (i & 3) + 8 * (i >> 2)]; }
            }
            float mt = fmaxf(s0[0], s1[0]);
#pragma unroll
            for (int i = 1; i < 16; ++i) mt = fmaxf(mt, fmaxf(s0[i], s1[i]));
            mt = fmaxf(mt, __shfl_xor(mt, 32));
            const float mn = fmaxf(m, mt), alpha = __builtin_amdgcn_exp2f(m - mn); m = mn;
            float ps = 0.f;
#pragma unroll
            for (int i = 0; i < 16; ++i) { s0[i] = __builtin_amdgcn_exp2f(s0[i] - mn); s1[i] = __builtin_amdgcn_exp2f(s1[i] - mn); ps += s0[i] + s1[i]; }
            l = l * alpha + ps;
#pragma unroll
            for (int db = 0; db < 4; ++db)
#pragma unroll
                for (int i = 0; i < 16; ++i) oacc[db][i] *= alpha;
            bf16x8_t pf[2][2];
#pragma unroll
            for (int sx = 0; sx < 2; ++sx) {
                v4u w0, w1;
                w0.x = cvt2bf(s0[8 * sx + 0], s0[8 * sx + 1]); w0.y = cvt2bf(s0[8 * sx + 2], s0[8 * sx + 3]); w0.z = cvt2bf(s0[8 * sx + 4], s0[8 * sx + 5]); w0.w = cvt2bf(s0[8 * sx + 6], s0[8 * sx + 7]);
                w1.x = cvt2bf(s1[8 * sx + 0], s1[8 * sx + 1]); w1.y = cvt2bf(s1[8 * sx + 2], s1[8 * sx + 3]); w1.z = cvt2bf(s1[8 * sx + 4], s1[8 * sx + 5]); w1.w = cvt2bf(s1[8 * sx + 6], s1[8 * sx + 7]);
                pf[0][sx] = __builtin_bit_cast(bf16x8_t, w0); pf[1][sx] = __builtin_bit_cast(bf16x8_t, w1);
            }
            const unsigned va = vrd + (unsigned)(cur * AT_VBUF);
            attn_pv<0>(oacc[0], va, pf); attn_pv<1>(oacc[1], va, pf); attn_pv<2>(oacc[2], va, pf); attn_pv<3>(oacc[3], va, pf);
        }
        if (t + 1 < nt) AT_WRITE(cur ^ 1);
        __syncthreads();
    }
#undef AT_LOAD
#undef AT_WRITE
    l += __shfl_xor(l, 32);
    const float inv = 1.0f / l;
    LAS float* xch = (LAS float*)lds + (size_t)qsub * 64 * 64 + lane;
    if (comp == 1) {
        const float sc = inv * lam;
#pragma unroll
        for (int db = 0; db < 4; ++db)
#pragma unroll
            for (int i = 0; i < 16; ++i) xch[(db * 16 + i) * 64] = oacc[db][i] * sc;
    }
    __syncthreads();
    if (comp == 0) {
        float ss = 0.f;
#pragma unroll
        for (int db = 0; db < 4; ++db)
#pragma unroll
            for (int i = 0; i < 16; ++i) { const float rv = oacc[db][i] * inv - xch[(db * 16 + i) * 64]; oacc[db][i] = rv; ss += rv * rv; }
        ss += __shfl_xor(ss, 32);
        const float rr = 0.8f / sqrtf(ss * (1.0f / 128.0f) + EPS);
        bf16* orow = mix + tq * 1024 + 512 + h * 128 + 4 * hh;
#pragma unroll
        for (int db = 0; db < 4; ++db)
#pragma unroll
            for (int g4 = 0; g4 < 4; ++g4) { const int dv0 = 32 * db + 8 * g4; const f32x4 gg = *(const f32x4*)(subln_g + dv0 + 4 * hh);
                v2u w; w.x = cvt2bf(oacc[db][4 * g4 + 0] * rr * gg[0], oacc[db][4 * g4 + 1] * rr * gg[1]); w.y = cvt2bf(oacc[db][4 * g4 + 2] * rr * gg[2], oacc[db][4 * g4 + 3] * rr * gg[3]);
                *(v2u*)(orow + dv0) = w; }
    }
}

__device__ __forceinline__ void wave_argmax(float& bv, int& bi) {
#pragma unroll
    for (int off = 32; off >= 1; off >>= 1) { const float ov = __shfl_xor(bv, off); const int oi = __shfl_xor(bi, off); const bool take = (ov > bv) || (ov == bv && oi < bi); bv = take ? ov : bv; bi = take ? oi : bi; }
}
__device__ __forceinline__ float gelu_tanh_f(float x) {
    const float t = x * (1.0f + 0.044715f * x * x) * (-2.3022082f);
    return x * __builtin_amdgcn_rcpf(1.0f + __builtin_amdgcn_exp2f(t));
}
__device__ __forceinline__ void peer_token(LAS unsigned char* wl, int t, int lane, const bf16* pq, const float* part2, const float* keys, const float* u_tab, const float* v_tab, const float* g_ffn, float* hio, bf16* hb, float* rs3) {
    LAS float* qs = (LAS float*)wl; LAS int* sel_e = (LAS int*)(wl + 1024); LAS float* sel_g = (LAS float*)(wl + 1536);
    float ps = lane < 16 ? part2[(size_t)t * 16 + lane] : 0.f; ps = wave_sum(ps);
    const float rs2 = 1.0f / sqrtf(ps * (1.0f / 1024.0f) + EPS);
    const float NEG = -__builtin_inff();
#pragma unroll 1
    for (int h = 0; h < 8; ++h) {
        { const v2u w = *(const v2u*)(pq + (size_t)t * 2048 + h * 256 + 4 * lane);
          *(LAS f32x4*)(qs + 4 * lane) = (f32x4){blo(w.x) * rs2, bhi(w.x) * rs2, blo(w.y) * rs2, bhi(w.y) * rs2}; }
        LDS_WAIT(); asm volatile("" ::: "memory");
        float sv[2]; int si[2];
#pragma unroll
        for (int c = 0; c < 2; ++c) {
            const f32x4* k0 = (const f32x4*)(keys + ((size_t)(h * 2 + c) * 128 + lane) * 128); const f32x4* k1 = k0 + 64 * 32;
            float a0 = 0.f, a1 = 0.f;
#pragma unroll 4
            for (int d4 = 0; d4 < 32; ++d4) { const f32x4 qv = *(const LAS f32x4*)(qs + c * 128 + 4 * d4); a0 += dot4(qv, k0[d4]); a1 += dot4(qv, k1[d4]); }
            float v0 = a0, v1 = a1; float tv = NEG; int ti = 0;
#pragma unroll 1
            for (int it = 0; it < 16; ++it) { float bv = v0 >= v1 ? v0 : v1; int bi = v0 >= v1 ? lane : lane + 64; wave_argmax(bv, bi);
                if (lane == it) { tv = bv; ti = bi; }
                if (bi == lane) v0 = NEG; if (bi == lane + 64) v1 = NEG; }
            sv[c] = tv; si[c] = ti;
        }
        const float a = __shfl(sv[0], lane >> 2);
        float cv[4];
#pragma unroll
        for (int r = 0; r < 4; ++r) cv[r] = a + __shfl(sv[1], (lane & 3) * 4 + r);
        float best = NEG; int bci = 0;
#pragma unroll 1
        for (int it = 0; it < 16; ++it) { float bv = cv[0]; int bi = 4 * lane;
#pragma unroll
            for (int r = 1; r < 4; ++r) if (cv[r] > bv) { bv = cv[r]; bi = 4 * lane + r; }
            wave_argmax(bv, bi);
            if (lane == it) { best = bv; bci = bi; }
#pragma unroll
            for (int r = 0; r < 4; ++r) if (bi == 4 * lane + r) cv[r] = NEG; }
        const int e1 = __shfl(si[0], (bci >> 4) & 15), e2 = __shfl(si[1], bci & 15);
        float mx = best;
#pragma unroll
        for (int off = 8; off >= 1; off >>= 1) mx = fmaxf(mx, __shfl_xor(mx, off));
        const float ex = lane < 16 ? __expf(best - mx) : 0.f; float sum = ex;
#pragma unroll
        for (int off = 8; off >= 1; off >>= 1) sum += __shfl_xor(sum, off);
        if (lane < 16) { sel_e[h * 16 + lane] = e1 * 128 + e2; sel_g[h * 16 + lane] = ex / sum; }
        LDS_WAIT(); asm volatile("" ::: "memory");
    }
    f32x4 hv[4], xn[4], acc[4];
#pragma unroll
    for (int j = 0; j < 4; ++j) { hv[j] = *(const f32x4*)(hio + (size_t)t * 1024 + 256 * j + 4 * lane); const f32x4 gv = *(const f32x4*)(g_ffn + 256 * j + 4 * lane); xn[j] = hv[j] * rs2 * gv; acc[j] = (f32x4){0.f, 0.f, 0.f, 0.f}; }
#pragma unroll 2
    for (int sidx = 0; sidx < 128; ++sidx) {
        const int e = sel_e[sidx]; const float g = sel_g[sidx];
        const f32x4* ur = (const f32x4*)(u_tab + (size_t)e * 1024) + lane; const f32x4* vr = (const f32x4*)(v_tab + (size_t)e * 1024) + lane;
        float d = 0.f;
#pragma unroll
        for (int j = 0; j < 4; ++j) d += dot4(ur[64 * j], xn[j]);
        d = wave_sum(d);
        const float coef = g * gelu_tanh_f(d);
#pragma unroll
        for (int j = 0; j < 4; ++j) acc[j] += coef * vr[64 * j];
    }
    float ss = 0.f;
#pragma unroll
    for (int j = 0; j < 4; ++j) { const f32x4 h2 = hv[j] + acc[j]; *(f32x4*)(hio + (size_t)t * 1024 + 256 * j + 4 * lane) = h2; ss += dot4(h2, h2);
        v2u w; w.x = pk2(h2[0], h2[1]); w.y = pk2(h2[2], h2[3]); *(v2u*)(hb + (size_t)t * 1024 + 256 * j + 4 * lane) = w; }
    ss = wave_sum(ss);
    if (lane == 0) rs3[t] = 1.0f / sqrtf(ss * (1.0f / 1024.0f) + EPS);
}

struct Args { const float* in[25]; float* out; unsigned char* ws; int ph_lo, ph_hi; };

#define AS4 __attribute__((address_space(4)))
#define KARGS_HERE const Args AS4* ap = (const Args AS4*)__builtin_amdgcn_kernarg_segment_ptr(); asm volatile("" : "+s"(ap))
__global__ void __launch_bounds__(NWAVES * 64, 2) fwd(Args args) {
    extern __shared__ __attribute__((aligned(16))) unsigned char lds_raw[];
    LAS unsigned char* lds = (LAS unsigned char*)lds_raw;
    volatile LAS unsigned* MISC = (volatile LAS unsigned*)(lds + MISC_OFF);
    const int tid = threadIdx.x, lane = tid & 63, wave = __builtin_amdgcn_readfirstlane(tid >> 6);
    const int G = gridDim.x, bid = blockIdx.x;
    unsigned char* ws = args.ws;
    if (tid < 32) MISC[tid] = 0u;
    __syncthreads();
    XcdBarrier bar; bar.bar = (unsigned*)(ws + WS_CTL); bar.x = 0; bar.st = nullptr;
    if (N_LAUNCHES == 1) bar = xcd_barrier_post((unsigned*)(ws + WS_CTL), MISC + 8);
#define GRID_BAR() do { if (N_LAUNCHES == 1) xcd_barrier(bar); } while (0)
    const int lo = args.ph_lo, hi = args.ph_hi;
#ifdef ONLY_PHASE
#define IN(k) ((k) == ONLY_PHASE)
#else
#define IN(k) (lo <= (k) && (k) < hi)
#endif
#define IN_X       (ap->in[0])
#define IN_P       (ap->in[1])
#define IN_GMIX    (ap->in[2])
#define IN_WIN     (ap->in[3])
#define IN_LNG     (ap->in[4])
#define IN_LNB     (ap->in[5])
#define IN_WS      (ap->in[6])
#define IN_BS      (ap->in[7])
#define IN_BETA    (ap->in[8])
#define IN_LQ1     (ap->in[9])
#define IN_LK1     (ap->in[10])
#define IN_LQ2     (ap->in[11])
#define IN_LK2     (ap->in[12])
#define IN_SUBLN   (ap->in[13])
#define IN_RELB    (ap->in[14])
#define IN_WOUT    (ap->in[15])
#define IN_GFFN    (ap->in[16])
#define IN_WQ      (ap->in[17])
#define IN_KEYS    (ap->in[18])
#define IN_UTAB    (ap->in[19])
#define IN_VTAB    (ap->in[20])
#define IN_GPLE    (ap->in[21])
#define IN_WPLE    (ap->in[22])
#define IN_WGATE   (ap->in[23])
#define IN_GFINAL  (ap->in[24])
#define OUTP       (ap->out)
#define Win_t   ((bf16*)(ws + WS_WIN))
#define Wout_t  ((bf16*)(ws + WS_WOUT))
#define Wq_t    ((bf16*)(ws + WS_WQ))
#define Wgate_t ((bf16*)(ws + WS_WGATE))
#define Wple_t  ((bf16*)(ws + WS_WPLE))
#define rs1     ((float*)(ws + WS_RS1))
#define rs3     ((float*)(ws + WS_RS3))
#define part4   ((float*)(ws + WS_PART4))
#define part2   ((float*)(ws + WS_PART2))
#define Abuf    ((bf16*)(ws + WS_A))
#define pb      ((bf16*)(ws + WS_PB))
#define pleb    ((bf16*)(ws + WS_PLE))
#define mix     ((bf16*)(ws + WS_M))
#define pq      ((bf16*)(ws + WS_M))
#define vbuf    ((bf16*)(ws + WS_F))
#define zA      ((bf16*)ap->out)
#define qbuf    ((bf16*)((unsigned char*)ap->out + 32 * MiB))
#define kbuf    ((bf16*)((unsigned char*)ap->out + 48 * MiB))
    const int gw = bid * NWAVES + wave, NGW = G * NWAVES;

    if (IN(0)) { KARGS_HERE;
        LAS float* scr = (LAS float*)(lds + wave * 16384);
        constexpr int I_IN = 16 * 80, I_OUT = 16 * 32, I_Q = 16 * 64, I_G = 16 * 32, I_P = 4 * 32;
        for (int it = gw; it < I_IN + I_OUT + I_Q + I_G + I_P; it += NGW) {
            int r = it;
            if (r < I_IN) { p0_transpose_item(IN_WIN, IN_GMIX, 1024, 2560, Win_t, scr, r, lane); continue; } r -= I_IN;
            if (r < I_OUT) { p0_transpose_item(IN_WOUT, nullptr, 1024, 1024, Wout_t, scr, r, lane); continue; } r -= I_OUT;
            if (r < I_Q) { p0_transpose_item(IN_WQ, IN_GFFN, 1024, 2048, Wq_t, scr, r, lane); continue; } r -= I_Q;
            if (r < I_G) { p0_transpose_item(IN_WGATE, IN_GPLE, 1024, 1024, Wgate_t, scr, r, lane); continue; } r -= I_G;
            p0_transpose_item(IN_WPLE, nullptr, 256, 1024, Wple_t, scr, r, lane);
        }
        for (int m = gw; m < T; m += NGW) {
            const f32x4* xr = (const f32x4*)(IN_X + (size_t)m * D) + lane; f32x4 v[4]; float s = 0.f;
#pragma unroll
            for (int j = 0; j < 4; ++j) { v[j] = xr[64 * j]; s += dot4(v[j], v[j]); }
            s = wave_sum(s);
            if (lane == 0) rs1[m] = 1.0f / sqrtf(s * (1.0f / 1024.0f) + EPS);
            v2u* o = (v2u*)(Abuf + (size_t)m * D) + lane;
#pragma unroll
            for (int j = 0; j < 4; ++j) { v2u w; w.x = pk2(v[j][0], v[j][1]); w.y = pk2(v[j][2], v[j][3]); o[64 * j] = w; }
            const f32x4 pv = *((const f32x4*)(IN_P + (size_t)m * 256) + lane); v2u w; w.x = pk2(pv[0], pv[1]); w.y = pk2(pv[2], pv[3]); *((v2u*)(pb + (size_t)m * 256) + lane) = w;
        }
        if (IN(1)) GRID_BAR();
    }
    if (IN(1)) { KARGS_HERE;
        { pg8::Gemm g{Abuf, Win_t, T, 2560, 1024}; pg8::StaticOrder S; S.init(T, 2560, G, bid);
          pg8::EpiZ E{zA, qbuf, kbuf, vbuf, rs1, 0.125f * 1.44269504f};
          pg8::gemm_phase<pg8::EpiZ, pg8::StaticOrder, true, true>(lds, g, S, E); }
        { pg8::Gemm g{pb, Wple_t, T, 1024, 256}; pg8::StaticOrder S; S.init(T, 1024, G, bid);
          pg8::EpiBf E{pleb, 1024};
          pg8::gemm_phase<pg8::EpiBf, pg8::StaticOrder, true, true>(lds, g, S, E); }
        if (IN(2)) GRID_BAR();
    }
    if (IN(2)) { KARGS_HERE;
#ifdef PROBE_P2_TWICE
        for (int rep = 0; rep < 2; ++rep) {
#endif
        for (int u = bid; u < 512; u += G) gmlp_unit(lds, u >> 2, u & 3, zA, IN_LNG, IN_LNB, IN_WS, IN_BS, IN_BETA, mix, tid);
        float lam;
        { const float a = IN_LQ1[lane] * IN_LK1[lane], b2 = IN_LQ2[lane] * IN_LK2[lane]; lam = __expf(wave_sum(a)) - __expf(wave_sum(b2)) + 0.2f; }
        for (int i = 0; i < 2; ++i) { const int u = i * G + bid; if (u >= 512) break;
            const int bh = u & 15, jp = (u >> 4) & 15, jb = (u < 256) ? 31 - jp : jp;
            attn_unit(lds, bh >> 2, bh & 3, jb, qbuf, kbuf, vbuf, IN_RELB, lam, IN_SUBLN, mix, tid, lane, wave); }
#ifdef PROBE_P2_TWICE
        }
#endif
        if (IN(3)) GRID_BAR();
    }
    if (IN(3)) { KARGS_HERE;
        pg8::Gemm g{mix, Wout_t, T, 1024, 1024}; pg8::StaticOrder S; S.init(T, 1024, G, bid);
        pg8::EpiRes E{IN_X, OUTP, Abuf, part2};
        pg8::gemm_phase<pg8::EpiRes, pg8::StaticOrder, true, true>(lds, g, S, E);
        if (IN(4)) GRID_BAR();
    }
    if (IN(4)) { KARGS_HERE;
        pg8::Gemm g{Abuf, Wq_t, T, 2048, 1024}; pg8::StaticOrder S; S.init(T, 2048, G, bid);
        pg8::EpiBf E{pq, 2048};
        pg8::gemm_phase<pg8::EpiBf, pg8::StaticOrder, true, true>(lds, g, S, E);
        if (IN(5)) GRID_BAR();
    }
    if (IN(5)) { KARGS_HERE;
        for (int t = gw; t < T; t += NGW) peer_token(lds + wave * 2048, t, lane, pq, part2, IN_KEYS, IN_UTAB, IN_VTAB, IN_GFFN, OUTP, Abuf, rs3);
        if (IN(6)) GRID_BAR();
    }
    if (IN(6)) { KARGS_HERE;
        pg8::Gemm g{Abuf, Wgate_t, T, 1024, 1024}; pg8::StaticOrder S; S.init(T, 1024, G, bid);
        pg8::EpiGate E{OUTP, pleb, rs3, part4};
        pg8::gemm_phase<pg8::EpiGate, pg8::StaticOrder, true, true>(lds, g, S, E);
        if (IN(7)) GRID_BAR();
    }
    if (IN(7)) { KARGS_HERE;
        for (int m = gw; m < T; m += NGW) {
            float ps = lane < 16 ? part4[(size_t)m * 16 + lane] : 0.f; ps = wave_sum(ps);
            const float r = 1.0f / sqrtf(ps * (1.0f / 1024.0f) + EPS);
            f32x4* hr = (f32x4*)(OUTP + (size_t)m * D) + lane;
#pragma unroll
            for (int j = 0; j < 4; ++j) { const f32x4 gv = *((const f32x4*)IN_GFINAL + 64 * j + lane); hr[64 * j] = hr[64 * j] * r * gv; }
        }
    }
#undef IN
#undef GRID_BAR
}

extern "C" void kernel_launch(void* const* d_in, const int* in_sizes, int n_in, void* d_out, int out_size, void* d_ws, size_t ws_size, hipStream_t stream) {
    static int grid = 0;
    if (grid == 0) {
        if (n_in != 25 || out_size != T * D || ws_size < WS_END) { fprintf(stderr, "kernel_launch: unexpected shapes (n_in %d, out %d, ws %zu)\n", n_in, out_size, ws_size); grid = -1; return; }
        int dev = 0, cus = 0, per_cu = 0;
        if (hipGetDevice(&dev) != hipSuccess || hipDeviceGetAttribute(&cus, hipDeviceAttributeMultiprocessorCount, dev) != hipSuccess) { grid = -1; return; }
        if (hipFuncSetAttribute((const void*)fwd, hipFuncAttributeMaxDynamicSharedMemorySize, LDS_BYTES) != hipSuccess) { fprintf(stderr, "kernel_launch: hipFuncSetAttribute failed\n"); grid = -1; return; }
        if (hipOccupancyMaxActiveBlocksPerMultiprocessor(&per_cu, (const void*)fwd, NWAVES * 64, LDS_BYTES) != hipSuccess || per_cu < 1) { fprintf(stderr, "kernel_launch: occupancy query says %d blocks per CU\n", per_cu); }
        (void)hipGetLastError();
        grid = cus;
    }
    if (grid < 0) return;
    if (N_LAUNCHES == 1) (void)hipMemsetAsync((char*)d_ws + WS_CTL, 0, CTL_ZERO_BYTES, stream);
    Args a{};
    for (int i = 0; i < 25; ++i) a.in[i] = (const float*)d_in[i];
    a.out = (float*)d_out; a.ws = (unsigned char*)d_ws;
    if (N_LAUNCHES == 1) { a.ph_lo = 0; a.ph_hi = NPHASE; hipLaunchKernelGGL(fwd, dim3(grid), dim3(NWAVES * 64), LDS_BYTES, stream, a); }
    else for (int li = 0; li < NPHASE; ++li) { a.ph_lo = li; a.ph_hi = li + 1; hipLaunchKernelGGL(fwd, dim3(grid), dim3(NWAVES * 64), LDS_BYTES, stream, a); }
}
```

```cpp
#include <hip/hip_runtime.h>
#include <cstdio>
#include <cstdint>
namespace pg8 {
#define PG8_LAS __attribute__((address_space(3)))
typedef unsigned short bf16_t;
typedef short bf16x8 __attribute__((ext_vector_type(8)));
typedef float f32x4 __attribute__((ext_vector_type(4)));
typedef unsigned u32x4 __attribute__((ext_vector_type(4)));
constexpr int BM = 256, BK = 64, HALF = 128, HTB = HALF * BK * 2  , STAGE_BYTES = 8 * HTB, NXCD = 8, WGM = 8;

__host__ __device__ __forceinline__ int lds_byte(int r, int c) { const int st = (r >> 4) * 2 + (c >> 5), rr = r & 15, cc = c & 31, ob = rr * 64 + cc * 2; return st * 1024 + (ob ^ (((ob >> 9) & 1) << 5)); }
__host__ __device__ __forceinline__ void stage_rc(int b, int& R, int& C) { const int st = b / 1024, sb = b % 1024, swz = sb ^ (((sb >> 9) & 1) << 5); R = (st >> 1) * 16 + swz / 64; C = (st & 1) * 32 + (swz % 64) / 2; }
__host__ __device__ __forceinline__ int perm32(int rho) { const int n = rho >> 4, i = rho & 15; return 8 * (i >> 2) + 4 * n + (i & 3); }

struct Unit { int pm, pn; };
struct Gemm { const bf16_t* A; const bf16_t* Bt; int M, N, K; };

struct StaticOrder {
    int nM, nN, nwg, G, c;
    __host__ __device__ void init(int M, int N, int G_, int c_) { nM = M / BM; nN = N / BM; nwg = nM * nN; G = G_; c = c_; }
    __host__ __device__ bool next(int i, Unit& u) const {
        const long L = (long)i * G + c; if (L >= nwg) return false;
        int wgid = (int)L; { const int q = nwg / NXCD, r = nwg % NXCD, xcd = wgid % NXCD, off = wgid / NXCD; wgid = (xcd < r ? xcd * (q + 1) : r * (q + 1) + (xcd - r) * q) + off; }
        const int nig = WGM * nN, gid = wgid / nig, fm = gid * WGM, gsz = (nM - fm) < WGM ? (nM - fm) : WGM;
        u.pm = fm + ((wgid % nig) % gsz); u.pn = (wgid % nig) / gsz; return true;
    }
    __device__ __forceinline__ void a_ready(const Unit&) const {}
    __device__ __forceinline__ void done(const Unit&) const {}
};


__device__ __forceinline__ unsigned cvt_pk_bf16(float lo, float hi) { unsigned r; asm volatile("v_cvt_pk_bf16_f32 %0, %1, %2" : "=v"(r) : "v"(lo), "v"(hi)); return r; }
typedef unsigned u32x2 __attribute__((ext_vector_type(2)));
__device__ __forceinline__ float gelu_tanh(float x) {
    const float t = x * (1.0f + 0.044715f * x * x) * (-2.3022082f);
    return x * __builtin_amdgcn_rcpf(1.0f + __builtin_amdgcn_exp2f(t));
}
__device__ __forceinline__ float bf_lo(unsigned w) { return __uint_as_float(w << 16); }
__device__ __forceinline__ float bf_hi(unsigned w) { return __uint_as_float(w & 0xffff0000u); }

struct EpiZ {
    static constexpr bool PERM = true, AFTER_DRAIN = false;
    bf16_t *zA, *q, *k, *v; const float* rs; float qscale;
    __device__ __forceinline__ void operator()(const f32x4 (&acc)[2][2][4][2], const Unit& u, int wr, int wc, int fr, int fq) const {
        const int pn = u.pn; bf16_t* base; int ldc, colt; float sc = 1.f; bool act = false;
        if (pn < 4) { base = zA; ldc = 1024; colt = pn * BM; act = true; }
        else if (pn < 6) { base = q; ldc = 512; colt = (pn - 4) * BM; sc = qscale; }
        else if (pn < 8) { base = k; ldc = 512; colt = (pn - 6) * BM; }
        else { base = v; ldc = 512; colt = (pn - 8) * BM; }
        const int row0 = u.pm * BM + wr * 64 + fr, col0 = colt + wc * 32 + 8 * fq;
#pragma unroll
        for (int ai = 0; ai < 2; ++ai)
#pragma unroll
            for (int m = 0; m < 4; ++m) { const int r = row0 + ai * HALF + m * 16; const float s = rs[r] * sc; bf16_t* rowp = base + (size_t)r * ldc + col0;
#pragma unroll
                for (int bj = 0; bj < 2; ++bj) { f32x4 v0 = acc[ai][bj][m][0] * s, v1 = acc[ai][bj][m][1] * s;
                    if (act) {
#pragma unroll
                        for (int j = 0; j < 4; ++j) { v0[j] = gelu_tanh(v0[j]); v1[j] = gelu_tanh(v1[j]); } }
                    u32x4 w; w.x = cvt_pk_bf16(v0[0], v0[1]); w.y = cvt_pk_bf16(v0[2], v0[3]); w.z = cvt_pk_bf16(v1[0], v1[1]); w.w = cvt_pk_bf16(v1[2], v1[3]);
                    *(u32x4*)(rowp + bj * HALF) = w; }
                asm volatile("" ::: "memory"); }
    }
};
struct EpiBf {
    static constexpr bool PERM = true, AFTER_DRAIN = false;
    bf16_t* O; int ldc;
    __device__ __forceinline__ void operator()(const f32x4 (&acc)[2][2][4][2], const Unit& u, int wr, int wc, int fr, int fq) const {
        const int row0 = u.pm * BM + wr * 64 + fr, col0 = u.pn * BM + wc * 32 + 8 * fq;
#pragma unroll
        for (int ai = 0; ai < 2; ++ai)
#pragma unroll
            for (int m = 0; m < 4; ++m) { bf16_t* rowp = O + (size_t)(row0 + ai * HALF + m * 16) * ldc + col0;
#pragma unroll
                for (int bj = 0; bj < 2; ++bj) { const f32x4 v0 = acc[ai][bj][m][0], v1 = acc[ai][bj][m][1];
                    u32x4 w; w.x = cvt_pk_bf16(v0[0], v0[1]); w.y = cvt_pk_bf16(v0[2], v0[3]); w.z = cvt_pk_bf16(v1[0], v1[1]); w.w = cvt_pk_bf16(v1[2], v1[3]);
                    *(u32x4*)(rowp + bj * HALF) = w; } }
    }
};
struct EpiRes {
    static constexpr bool PERM = false, AFTER_DRAIN = false;
    const float* base; float* out; bf16_t* hb; float* part;
    __device__ __forceinline__ void operator()(const f32x4 (&acc)[2][2][4][2], const Unit& u, int wr, int wc, int fr, int fq) const {
        const int row0 = u.pm * BM + wr * 64 + fr, col0 = u.pn * BM + wc * 32 + 4 * fq;
#pragma unroll
        for (int ai = 0; ai < 2; ++ai)
#pragma unroll
            for (int m = 0; m < 4; ++m) { const int r = row0 + ai * HALF + m * 16; const size_t off = (size_t)r * 1024 + col0; float ss = 0.f;
#pragma unroll
                for (int bj = 0; bj < 2; ++bj)
#pragma unroll
                    for (int n = 0; n < 2; ++n) { const size_t o = off + bj * HALF + n * 16; const f32x4 b = *(const f32x4*)(base + o); const f32x4 h = b + acc[ai][bj][m][n];
                        *(f32x4*)(out + o) = h; ss += (h[0] * h[0] + h[1] * h[1]) + (h[2] * h[2] + h[3] * h[3]);
                        u32x2 w; w.x = cvt_pk_bf16(h[0], h[1]); w.y = cvt_pk_bf16(h[2], h[3]); *(u32x2*)(hb + o) = w; }
                ss += __shfl_xor(ss, 16); ss += __shfl_xor(ss, 32);
                if (fq == 0) part[(size_t)r * 16 + u.pn * 4 + wc] = ss; }
    }
};
struct EpiGate {
    static constexpr bool PERM = false, AFTER_DRAIN = false;
    float* hio; const bf16_t* ple; const float* rs; float* part;
    __device__ __forceinline__ void operator()(const f32x4 (&acc)[2][2][4][2], const Unit& u, int wr, int wc, int fr, int fq) const {
        const int row0 = u.pm * BM + wr * 64 + fr, col0 = u.pn * BM + wc * 32 + 4 * fq;
#pragma unroll
        for (int ai = 0; ai < 2; ++ai)
#pragma unroll
            for (int m = 0; m < 4; ++m) { const int r = row0 + ai * HALF + m * 16; const size_t off = (size_t)r * 1024 + col0; float ss = 0.f; const float s = rs[r] * (-1.44269504f);
#pragma unroll
                for (int bj = 0; bj < 2; ++bj)
#pragma unroll
                    for (int n = 0; n < 2; ++n) { const size_t o = off + bj * HALF + n * 16; f32x4 h = *(const f32x4*)(hio + o); const u32x2 pw = *(const u32x2*)(ple + o);
                        const f32x4 a = acc[ai][bj][m][n]; f32x4 g;
#pragma unroll
                        for (int j = 0; j < 4; ++j) g[j] = __builtin_amdgcn_rcpf(1.0f + __builtin_amdgcn_exp2f(a[j] * s));
                        h[0] += bf_lo(pw.x) * g[0]; h[1] += bf_hi(pw.x) * g[1]; h[2] += bf_lo(pw.y) * g[2]; h[3] += bf_hi(pw.y) * g[3];
                        *(f32x4*)(hio + o) = h; ss += (h[0] * h[0] + h[1] * h[1]) + (h[2] * h[2] + h[3] * h[3]); }
                ss += __shfl_xor(ss, 16); ss += __shfl_xor(ss, 32);
                if (fq == 0) part[(size_t)r * 16 + u.pn * 4 + wc] = ss; }
    }
};

template <class Epi, class Sched, bool ALIGN_EPI = false, bool SP2 = false>
__device__ __forceinline__ void gemm_phase(PG8_LAS unsigned char* lds, const Gemm g, const Sched& S, const Epi& E) {
    const int tid = threadIdx.x, wid = __builtin_amdgcn_readfirstlane(tid >> 6), lane = tid & 63, wr = wid >> 2, wc = wid & 3, fr = lane & 15, fq = lane >> 4;
    const int K = g.K, nt = K / BK;
    unsigned voffA[2], voffB[2];
#pragma unroll
    for (int i = 0; i < 2; ++i) { int R, C; stage_rc(tid * 16 + i * 8192, R, C); const int Rb = Epi::PERM ? ((R & ~31) + perm32(R & 31)) : R;
        voffA[i] = (unsigned)(R * K + C) * 2u; voffB[i] = (unsigned)(Rb * K + C) * 2u; }
    const size_t kstep = (size_t)(BK * 2);
    const size_t hstep = (size_t)HALF * K * 2;
    const size_t tstep = 2 * hstep;
    const unsigned ldsw = (unsigned)wid * 1024u;
    const int aoff = lds_byte(wr * 64 + fr, fq * 8), boff = lds_byte(wc * 32 + fr, fq * 8);
#define PG8_SA(b, h) (((b) * 2 + (h)) * HTB)
#define PG8_SB(b, h) ((4 + (b) * 2 + (h)) * HTB)
#define PG8_STAGE(bufoff, gbase, voff) do { _Pragma("unroll") for (int _i = 0; _i < 2; ++_i) \
        __builtin_amdgcn_global_load_lds((const unsigned*)((const char*)(gbase) + (voff)[_i]), (PG8_LAS unsigned*)(lds + (bufoff) + ldsw + _i * 8192), 16, 0, 0); } while (0)
#define PG8_LDA(dst, b, h) do { _Pragma("unroll") for (int m = 0; m < 4; ++m) _Pragma("unroll") for (int k = 0; k < 2; ++k) dst[m][k] = *(const PG8_LAS bf16x8*)(lds + PG8_SA(b, h) + aoff + m * 2048 + k * 1024); } while (0)
#define PG8_LDB(dst, b, h) do { _Pragma("unroll") for (int n = 0; n < 2; ++n) _Pragma("unroll") for (int k = 0; k < 2; ++k) dst[n][k] = *(const PG8_LAS bf16x8*)(lds + PG8_SB(b, h) + boff + n * 2048 + k * 1024); } while (0)
#define PG8_MMA(ai, bj, At, Bt) do { __builtin_amdgcn_s_setprio(1); _Pragma("unroll") for (int m = 0; m < 4; ++m) _Pragma("unroll") for (int n = 0; n < 2; ++n) _Pragma("unroll") for (int k = 0; k < 2; ++k) \
        acc[ai][bj][m][n] = __builtin_amdgcn_mfma_f32_16x16x32_bf16(Bt[n][k], At[m][k], acc[ai][bj][m][n], 0, 0, 0); __builtin_amdgcn_s_setprio(0); } while (0)
#define PG8_WAIT_V(n) asm volatile("s_waitcnt vmcnt(" #n ")" ::: "memory")
#define PG8_WAIT_L(n) asm volatile("s_waitcnt lgkmcnt(" #n ")" ::: "memory")
#define PG8_BAR __builtin_amdgcn_s_barrier()
#define PG8_SCHED __builtin_amdgcn_sched_barrier(0)
    Unit cur, nxt; int ui = 0;
    if (!S.next(0, cur)) return;
    f32x4 acc[2][2][4][2];
#pragma unroll
    for (int a = 0; a < 2; ++a)
#pragma unroll
        for (int b = 0; b < 2; ++b)
#pragma unroll
            for (int m = 0; m < 4; ++m)
#pragma unroll
                for (int n = 0; n < 2; ++n) acc[a][b][m][n] = (f32x4){0.f, 0.f, 0.f, 0.f};
    bf16x8 At[4][2], B0[2][2], B1[2][2];
    const char* cA = (const char*)g.A + (size_t)cur.pm * tstep; const char* cB = (const char*)g.Bt + (size_t)cur.pn * tstep;
    S.a_ready(cur);
    if constexpr (SP2) {
        PG8_STAGE(PG8_SB(0, 0), cB, voffB); PG8_STAGE(PG8_SB(0, 1), cB + hstep, voffB); PG8_STAGE(PG8_SA(0, 0), cA, voffA); PG8_STAGE(PG8_SA(0, 1), cA + hstep, voffA);
        if (wr == 1) PG8_BAR;
        PG8_WAIT_V(2); PG8_BAR;
        PG8_STAGE(PG8_SB(1, 0), cB + kstep, voffB); PG8_STAGE(PG8_SA(1, 0), cA + kstep, voffA); PG8_STAGE(PG8_SB(1, 1), cB + hstep + kstep, voffB);
        PG8_WAIT_V(6); PG8_BAR;
    } else {
        PG8_STAGE(PG8_SB(0, 0), cB, voffB); PG8_STAGE(PG8_SA(0, 0), cA, voffA); PG8_STAGE(PG8_SB(0, 1), cB + hstep, voffB); PG8_STAGE(PG8_SA(0, 1), cA + hstep, voffA);
        if (wr == 1) PG8_BAR;
        PG8_WAIT_V(4); PG8_BAR;
        PG8_STAGE(PG8_SB(1, 0), cB + kstep, voffB); PG8_STAGE(PG8_SA(1, 0), cA + kstep, voffA); PG8_STAGE(PG8_SB(1, 1), cB + hstep + kstep, voffB);
        PG8_WAIT_V(6); PG8_BAR;
    }
    for (;;) {
        const bool has_next = S.next(ui + 1, nxt);
        const char* nA = has_next ? (const char*)g.A + (size_t)nxt.pm * tstep : cA; const char* nB = has_next ? (const char*)g.Bt + (size_t)nxt.pn * tstep : cB;
        for (int t = 0; t < nt; t += 2) {
            const bool last = (t == nt - 2);
            const char* a1 = cA + (size_t)(t + 1) * kstep;
            const char* a2 = last ? nA : cA + (size_t)(t + 2) * kstep; const char* b2 = last ? nB : cB + (size_t)(t + 2) * kstep;
            const char* a3 = a2 + kstep; const char* b3 = b2 + kstep;
            if (last && has_next) S.a_ready(nxt);
            if constexpr (SP2) {
            PG8_LDB(B0, 0, 0); PG8_LDB(B1, 0, 1); PG8_SCHED; PG8_LDA(At, 0, 0); PG8_STAGE(PG8_SA(1, 1), a1 + hstep, voffA);
            PG8_WAIT_V(8); PG8_WAIT_L(0); PG8_BAR; PG8_MMA(0, 0, At, B0); PG8_MMA(0, 1, At, B1); PG8_BAR; PG8_SCHED;
            PG8_LDA(At, 0, 1); PG8_STAGE(PG8_SB(0, 0), b2, voffB); PG8_STAGE(PG8_SB(0, 1), b2 + hstep, voffB); PG8_STAGE(PG8_SA(0, 0), a2, voffA);
            PG8_WAIT_V(8); PG8_WAIT_L(0); PG8_BAR; PG8_MMA(1, 0, At, B0); PG8_MMA(1, 1, At, B1); PG8_BAR; PG8_SCHED;
            PG8_LDB(B0, 1, 0); PG8_LDB(B1, 1, 1); PG8_SCHED; PG8_LDA(At, 1, 0); PG8_STAGE(PG8_SA(0, 1), a2 + hstep, voffA);
            PG8_WAIT_V(8); PG8_WAIT_L(0); PG8_BAR; PG8_MMA(0, 0, At, B0); PG8_MMA(0, 1, At, B1); PG8_BAR; PG8_SCHED;
            PG8_LDA(At, 1, 1); PG8_STAGE(PG8_SB(1, 0), b3, voffB); PG8_STAGE(PG8_SB(1, 1), b3 + hstep, voffB); PG8_STAGE(PG8_SA(1, 0), a3, voffA);
            PG8_WAIT_V(8); PG8_WAIT_L(0); PG8_BAR; PG8_MMA(1, 0, At, B0); PG8_MMA(1, 1, At, B1); PG8_BAR; PG8_SCHED;
            } else {
            PG8_LDB(B0, 0, 0); PG8_SCHED; PG8_LDA(At, 0, 0); PG8_STAGE(PG8_SA(1, 1), a1 + hstep, voffA);
            PG8_WAIT_L(8); PG8_BAR; PG8_WAIT_L(0); PG8_MMA(0, 0, At, B0); PG8_BAR; PG8_SCHED;
            PG8_LDB(B1, 0, 1); PG8_STAGE(PG8_SB(0, 0), b2, voffB);
            PG8_BAR; PG8_WAIT_L(0); PG8_MMA(0, 1, At, B1); PG8_BAR;
            PG8_LDA(At, 0, 1); PG8_STAGE(PG8_SA(0, 0), a2, voffA);
            PG8_BAR; PG8_WAIT_L(0); PG8_MMA(1, 0, At, B0); PG8_BAR; PG8_SCHED;
            PG8_STAGE(PG8_SB(0, 1), b2 + hstep, voffB);
            PG8_WAIT_V(6); PG8_BAR; PG8_MMA(1, 1, At, B1); PG8_BAR;
            PG8_LDB(B0, 1, 0); PG8_SCHED; PG8_LDA(At, 1, 0); PG8_STAGE(PG8_SA(0, 1), a2 + hstep, voffA);
            PG8_WAIT_L(8); PG8_BAR; PG8_WAIT_L(0); PG8_MMA(0, 0, At, B0); PG8_BAR; PG8_SCHED;
            PG8_LDB(B1, 1, 1); PG8_STAGE(PG8_SB(1, 0), b3, voffB);
            PG8_BAR; PG8_WAIT_L(0); PG8_MMA(0, 1, At, B1); PG8_BAR;
            PG8_LDA(At, 1, 1); PG8_STAGE(PG8_SA(1, 0), a3, voffA);
            PG8_BAR; PG8_WAIT_L(0); PG8_MMA(1, 0, At, B0); PG8_BAR; PG8_SCHED;
            PG8_STAGE(PG8_SB(1, 1), b3 + hstep, voffB);
            PG8_WAIT_V(6); PG8_BAR; PG8_MMA(1, 1, At, B1); PG8_BAR;
            }
        }
        if constexpr (ALIGN_EPI) { if (wr == 0) PG8_BAR; }
        if constexpr (!Epi::AFTER_DRAIN) { E(acc, cur, wr, wc, fr, fq); S.done(cur); }
        if (!has_next) break;
#pragma unroll
        for (int a = 0; a < 2; ++a)
#pragma unroll
            for (int b = 0; b < 2; ++b)
#pragma unroll
                for (int m = 0; m < 4; ++m)
#pragma unroll
                    for (int n = 0; n < 2; ++n) acc[a][b][m][n] = (f32x4){0.f, 0.f, 0.f, 0.f};
        cur = nxt; cA = nA; cB = nB; ++ui;
        if constexpr (ALIGN_EPI) { if (wr == 1) PG8_BAR; }
    }
    PG8_WAIT_V(0);
    if constexpr (!ALIGN_EPI) { if (wr == 0) PG8_BAR; }
    PG8_BAR;
    if constexpr (Epi::AFTER_DRAIN) { E.fused(acc, cur, wr, wc, fr, fq, lds, wid, lane); S.done(cur); }
#undef PG8_SA
#undef PG8_SB
#undef PG8_STAGE
#undef PG8_LDA
#undef PG8_LDB
#undef PG8_MMA
#undef PG8_WAIT_V
#undef PG8_WAIT_L
#undef PG8_BAR
#undef PG8_SCHED
}
}

constexpr int NWAVES = 8;
#ifndef MK_N_LAUNCHES
#define MK_N_LAUNCHES 1
#endif
constexpr int NPHASE = 9;
constexpr int N_LAUNCHES = MK_N_LAUNCHES;

constexpr int T = 16384, D = 1024, SEQ = 4096;
constexpr float EPS = 1e-6f;
constexpr size_t MiB = 1u << 20;
constexpr size_t WS_CTL = 0, CTL_ZERO_BYTES = 16384;
constexpr size_t WS_WIN = 1 * MiB, WS_WOUT = 6 * MiB, WS_WQ = 8 * MiB, WS_WGATE = 12 * MiB, WS_WPLE = 14 * MiB;
constexpr size_t WS_RS1 = 14 * MiB + 512 * 1024, WS_RS3 = WS_RS1 + 65536, WS_PART4 = 15 * MiB, WS_PART2 = 16 * MiB;
constexpr size_t WS_A = 17 * MiB;
constexpr size_t WS_PB = 49 * MiB;
constexpr size_t WS_PLE = 57 * MiB;
constexpr size_t WS_TAB = 89 * MiB;
constexpr size_t WS_SEL = 153 * MiB;
constexpr size_t WS_M = 169 * MiB;
constexpr size_t WS_F = 201 * MiB;
constexpr size_t WS_KEYSB = 240 * MiB;
constexpr size_t WS_END = 256 * MiB;
constexpr int RING_BYTES = 131072, MISC_OFF = RING_BYTES + 320, LDS_BYTES = 147456;

#define GAS __attribute__((address_space(1)))
#define LAS __attribute__((address_space(3)))
typedef unsigned short bf16;
typedef unsigned v4u __attribute__((ext_vector_type(4)));
typedef unsigned v2u __attribute__((ext_vector_type(2)));
typedef float f32x4 __attribute__((ext_vector_type(4)));
#define LDS_WAIT() asm volatile("s_waitcnt lgkmcnt(0)" ::: "memory")
__device__ __forceinline__ unsigned f2bf(float f) { unsigned u = __builtin_bit_cast(unsigned, f); return (u + 0x7fffu + ((u >> 16) & 1u)) >> 16; }
__device__ __forceinline__ unsigned pk2(float lo, float hi) { return f2bf(lo) | (f2bf(hi) << 16); }
__device__ __forceinline__ float blo(unsigned w) { return __uint_as_float(w << 16); }
__device__ __forceinline__ float bhi(unsigned w) { return __uint_as_float(w & 0xffff0000u); }
__device__ __forceinline__ float wave_sum(float v) {
#pragma unroll
    for (int o = 1; o < 64; o <<= 1) v += __shfl_xor(v, o);
    return v;
}
__device__ __forceinline__ float dot4(f32x4 a, f32x4 b) { return (a[0] * b[0] + a[1] * b[1]) + (a[2] * b[2] + a[3] * b[3]); }

#define XB_TMO      128
#define XB_XCNT(j)  (256  + 64 * (j))
#define XB_XSUB(j)  (1280 + 64 * (j))
#define XB_XGEN(j)  (2304 + 64 * (j))
#define XB_TOP      3328
#define XB_TOPGEN   3392
#define XCD_BAR_WORDS 3456
#define XB_SPIN_CAP (1u << 18)

__device__ __forceinline__ unsigned xb_ld(unsigned* p)              { return __hip_atomic_load(p, __ATOMIC_RELAXED, __HIP_MEMORY_SCOPE_AGENT); }
__device__ __forceinline__ unsigned xb_add(unsigned* p, unsigned v) { return __hip_atomic_fetch_add(p, v, __ATOMIC_RELAXED, __HIP_MEMORY_SCOPE_AGENT); }
__device__ __forceinline__ unsigned xb_xcc_id() { return (unsigned)__builtin_amdgcn_s_getreg((3 << 11) | 20) & 0xFu; }
#define XB_SPIN(cond, bar) do { unsigned _sp = 0; while (cond) { __builtin_amdgcn_s_sleep(1); \
    if ((++_sp & 255u) == 0u) { if (xb_ld(&(bar)[XB_TMO])) break; if (_sp > XB_SPIN_CAP) { atomicAdd(&(bar)[XB_TMO], 1u); break; } } } } while (0)

struct XcdBarrier {
    unsigned* bar; unsigned x;
    volatile LAS unsigned* st;
};

__device__ __forceinline__ XcdBarrier xcd_barrier_post(unsigned* bar, volatile LAS unsigned* st) {
    XcdBarrier b; b.bar = bar; b.x = xb_xcc_id(); b.st = st;
    if (threadIdx.x == 0) (void)xb_add(&bar[XB_XCNT(b.x)], 1u);
    return b;
}
__device__ __forceinline__ void xcd_barrier_complete(unsigned* bar, unsigned x, unsigned& nloc, unsigned& nx) {
    const unsigned G = gridDim.x * gridDim.y * gridDim.z;
    unsigned sum, cnt, mine, sp = 0u;
    for (;;) {
        sum = 0u; cnt = 0u; mine = 0u;
#pragma unroll
        for (unsigned j = 0; j < 16; ++j) { const unsigned c = xb_ld(&bar[XB_XCNT(j)]); sum += c; cnt += (c > 0u) ? 1u : 0u; mine = (j == x) ? c : mine; }
        if (sum == G) break;
        __builtin_amdgcn_s_sleep(1);
        if ((++sp & 255u) == 0u) { if (xb_ld(&bar[XB_TMO])) break; if (sp > XB_SPIN_CAP) { atomicAdd(&bar[XB_TMO], 1u); break; } }
    }
    nloc = mine > 0u ? mine : 1u; nx = cnt > 0u ? cnt : 1u;
}

__device__ __forceinline__ void xcd_barrier(const XcdBarrier& b) {
    asm volatile("s_waitcnt vmcnt(0)" ::: "memory");
    __syncthreads();
    if (threadIdx.x == 0) {
        unsigned* bar = b.bar;
        __builtin_amdgcn_s_waitcnt(0);
        unsigned nloc = b.st[0], nx = b.st[1];
        if (nloc == 0u) { xcd_barrier_complete(bar, b.x, nloc, nx); b.st[0] = nloc; b.st[1] = nx; }
        const unsigned old = xb_add(&bar[XB_XSUB(b.x)], 1u);
        const unsigned gen = old / nloc;
        if (old + 1u == (gen + 1u) * nloc) {
            __builtin_amdgcn_fence(__ATOMIC_RELEASE, "agent");
            asm volatile("s_waitcnt vmcnt(0)" ::: "memory");
            const unsigned og = xb_add(&bar[XB_TOP], 1u);
            const unsigned tg = og / nx;
            if (og + 1u == (tg + 1u) * nx) xb_add(&bar[XB_TOPGEN], 1u);
            else XB_SPIN(xb_ld(&bar[XB_TOPGEN]) == tg, bar);
            __builtin_amdgcn_fence(__ATOMIC_ACQUIRE, "agent");
            xb_add(&bar[XB_XGEN(b.x)], 1u);
            asm volatile("s_waitcnt vmcnt(0)" ::: "memory");
        } else {
            XB_SPIN(xb_ld(&bar[XB_XGEN(b.x)]) == gen, bar);
            __builtin_amdgcn_fence(__ATOMIC_ACQUIRE, "agent");
            asm volatile("s_waitcnt vmcnt(0)" ::: "memory");
        }
    }
    __syncthreads();
}

__device__ __forceinline__ void p0_transpose_item(const float* W, const float* gain, int K, int N, bf16* WT, LAS float* scr, int item, int lane) {
    const int nblk = N / 32, kb = item / nblk, nb = item % nblk, k0 = 64 * kb, n0 = 32 * nb;
#pragma unroll 8
    for (int i = 0; i < 32; ++i) { const int kk = 2 * i + (lane >> 5); const float g = gain ? gain[k0 + kk] : 1.0f; scr[kk * 33 + (lane & 31)] = W[(size_t)(k0 + kk) * N + n0 + (lane & 31)] * g; }
    LDS_WAIT(); asm volatile("" ::: "memory");
    const int c = lane & 7;
#pragma unroll
    for (int j = 0; j < 4; ++j) { const int n = (lane >> 3) + 8 * j; const LAS float* s = scr + (8 * c) * 33 + n;
        v4u o; o.x = pk2(s[0 * 33], s[1 * 33]); o.y = pk2(s[2 * 33], s[3 * 33]); o.z = pk2(s[4 * 33], s[5 * 33]); o.w = pk2(s[6 * 33], s[7 * 33]);
        *(v4u*)(WT + (size_t)(n0 + n) * K + k0 + 8 * c) = o; }
    LDS_WAIT(); asm volatile("" ::: "memory");
}

__device__ __forceinline__ int t5_bucket(int rel) {
    const int n = rel < 0 ? -rel : rel;
    const int large = 8 + (n >= 12) + (n >= 16) + (n >= 23) + (n >= 32) + (n >= 46) + (n >= 64) + (n >= 91);
    return (rel > 0 ? 16 : 0) + (n < 8 ? n : large);
}

__device__ __forceinline__ void gmlp_unit(LAS unsigned char* lds, int nb, int g, const bf16* zA, const float* ln_g, const float* ln_b, const float* w_s, const float* b_s, const float* beta, bf16* mix, int tid) {
    constexpr int VP = 132;
    LAS float* vln = (LAS float*)lds;
    const int i = tid >> 2, cq = tid & 3, t = nb * 128 + i, cb = g * 128 + cq * 32;
    float x[32];
    { const v4u* vp = (const v4u*)(zA + (size_t)t * 1024 + 512 + cb);
#pragma unroll
      for (int k = 0; k < 4; ++k) { const v4u w = vp[k]; x[8 * k + 0] = blo(w.x); x[8 * k + 1] = bhi(w.x); x[8 * k + 2] = blo(w.y); x[8 * k + 3] = bhi(w.y); x[8 * k + 4] = blo(w.z); x[8 * k + 5] = bhi(w.z); x[8 * k + 6] = blo(w.w); x[8 * k + 7] = bhi(w.w); } }
    float s = 0.f;
#pragma unroll
    for (int c = 0; c < 32; ++c) s += x[c];
    s += __shfl_xor(s, 1); s += __shfl_xor(s, 2);
    const float mean = s * (1.0f / 128.0f); float q = 0.f;
#pragma unroll
    for (int c = 0; c < 32; ++c) { x[c] -= mean; q += x[c] * x[c]; }
    q += __shfl_xor(q, 1); q += __shfl_xor(q, 2);
    const float rstd = 1.0f / sqrtf(q * (1.0f / 128.0f) + EPS);
#pragma unroll
    for (int k = 0; k < 8; ++k) { const f32x4 gg = *(const f32x4*)(ln_g + cb + 4 * k), bb = *(const f32x4*)(ln_b + cb + 4 * k); f32x4 y;
#pragma unroll
        for (int e = 0; e < 4; ++e) y[e] = x[4 * k + e] * rstd * gg[e] + bb[e];
        *(LAS f32x4*)(vln + i * VP + cq * 32 + 4 * k) = y; }
    __syncthreads();
    float acc[32];
#pragma unroll
    for (int c = 0; c < 32; ++c) acc[c] = 0.f;
    const int jmax = (i < 64) ? 64 : 128;
    const float* wrow = w_s + ((size_t)g * 128 + i) * 128;
    for (int j0 = 0; j0 < jmax; j0 += 4) { const f32x4 wv = *(const f32x4*)(wrow + j0);
#pragma unroll
        for (int jj = 0; jj < 4; ++jj)
#pragma unroll
            for (int k = 0; k < 8; ++k) { const f32x4 vv = *(const LAS f32x4*)(vln + (j0 + jj) * VP + cq * 32 + 4 * k);
#pragma unroll
                for (int e = 0; e < 4; ++e) acc[4 * k + e] += wv[jj] * vv[e]; } }
    const float bias = b_s[g * 128 + i];
    float ss = 0.f;
    { const v4u* up = (const v4u*)(zA + (size_t)t * 1024 + cb);
#pragma unroll
      for (int k = 0; k < 4; ++k) { const v4u w = up[k]; float u8[8] = {blo(w.x), bhi(w.x), blo(w.y), bhi(w.y), blo(w.z), bhi(w.z), blo(w.w), bhi(w.w)};
#pragma unroll
          for (int e = 0; e < 8; ++e) { const float o = u8[e] * (acc[8 * k + e] + bias); acc[8 * k + e] = o; ss += o * o; } } }
    ss += __shfl_xor(ss, 1); ss += __shfl_xor(ss, 2);
    const float rr = 1.0f / sqrtf(ss * (1.0f / 128.0f) + EPS);
    { v4u* op = (v4u*)(mix + (size_t)t * 1024 + cb);
#pragma unroll
      for (int k = 0; k < 4; ++k) { const f32x4 b0 = *(const f32x4*)(beta + cb + 8 * k), b1 = *(const f32x4*)(beta + cb + 8 * k + 4); v4u w;
          w.x = pk2(acc[8 * k + 0] * rr * b0[0], acc[8 * k + 1] * rr * b0[1]); w.y = pk2(acc[8 * k + 2] * rr * b0[2], acc[8 * k + 3] * rr * b0[3]);
          w.z = pk2(acc[8 * k + 4] * rr * b1[0], acc[8 * k + 5] * rr * b1[1]); w.w = pk2(acc[8 * k + 6] * rr * b1[2], acc[8 * k + 7] * rr * b1[3]); op[k] = w; } }
    __syncthreads();
}

typedef short bf16x8_t __attribute__((ext_vector_type(8)));
typedef short s16x4_t __attribute__((ext_vector_type(4)));
typedef float f32x16 __attribute__((ext_vector_type(16)));
typedef __bf16 bf2_t __attribute__((ext_vector_type(2)));
typedef float f2_t __attribute__((ext_vector_type(2)));
__device__ __forceinline__ unsigned cvt2bf(float a, float b) { const f2_t v = {a, b}; const bf2_t r = __builtin_convertvector(v, bf2_t); return __builtin_bit_cast(unsigned, r); }
template <int OFF> __device__ __forceinline__ s16x4_t tr_read(unsigned addr) { s16x4_t r; asm volatile("ds_read_b64_tr_b16 %0, %1 offset:%2" : "=&v"(r) : "v"(addr), "i"(OFF) : "memory"); return r; }
constexpr int AT_KP = 272, AT_VP = 320, AT_KBUF = 64 * AT_KP, AT_VBUF = 64 * AT_VP, AT_OFF_V = 2 * AT_KBUF, AT_OFF_BT = AT_OFF_V + 2 * AT_VBUF;
static_assert(AT_OFF_BT + 1024 <= RING_BYTES, "attention LDS map");
template <int DB> __device__ __forceinline__ void attn_pv(f32x16& o, unsigned va, const bf16x8_t (&pf)[2][2]) {
    const s16x4_t l00 = tr_read<0 * 32 * AT_VP + 0 * 16 * AT_VP + DB * 64>(va), h00 = tr_read<0 * 32 * AT_VP + 0 * 16 * AT_VP + 8 * AT_VP + DB * 64>(va);
    const s16x4_t l01 = tr_read<0 * 32 * AT_VP + 1 * 16 * AT_VP + DB * 64>(va), h01 = tr_read<0 * 32 * AT_VP + 1 * 16 * AT_VP + 8 * AT_VP + DB * 64>(va);
    const s16x4_t l10 = tr_read<1 * 32 * AT_VP + 0 * 16 * AT_VP + DB * 64>(va), h10 = tr_read<1 * 32 * AT_VP + 0 * 16 * AT_VP + 8 * AT_VP + DB * 64>(va);
    const s16x4_t l11 = tr_read<1 * 32 * AT_VP + 1 * 16 * AT_VP + DB * 64>(va), h11 = tr_read<1 * 32 * AT_VP + 1 * 16 * AT_VP + 8 * AT_VP + DB * 64>(va);
    asm volatile("s_waitcnt lgkmcnt(0)" ::: "memory"); __builtin_amdgcn_sched_barrier(0);
#define AT_PK(L, H) (bf16x8_t){L[0], L[1], L[2], L[3], H[0], H[1], H[2], H[3]}
    o = __builtin_amdgcn_mfma_f32_32x32x16_bf16(AT_PK(l00, h00), pf[0][0], o, 0, 0, 0);
    o = __builtin_amdgcn_mfma_f32_32x32x16_bf16(AT_PK(l01, h01), pf[0][1], o, 0, 0, 0);
    o = __builtin_amdgcn_mfma_f32_32x32x16_bf16(AT_PK(l10, h10), pf[1][0], o, 0, 0, 0);
    o = __builtin_amdgcn_mfma_f32_32x32x16_bf16(AT_PK(l11, h11), pf[1][1], o, 0, 0, 0);
#undef AT_PK
}
__device__ __forceinline__ void attn_unit(LAS unsigned char* lds, int b, int h, int jb, const bf16* qb, const bf16* kb, const bf16* vb, const float* rel_bias, float lam, const float* subln_g, bf16* mix, int tid, int lane, int wave) {
    const int comp = wave >> 2, qsub = wave & 3, r = lane & 31, hh = lane >> 5;
    const int cq = 2 * jb + (qsub >> 1), nt = 2 * jb + 2;
    const int qpos = 128 * jb + 32 * qsub + r;
    const size_t tq = (size_t)b * SEQ + qpos;
    LAS float* bt = (LAS float*)(lds + AT_OFF_BT);
    __syncthreads();
    if (tid < 256) bt[tid] = (rel_bias[t5_bucket(tid - 192) * 4 + h] - rel_bias[15 * 4 + h]) * 1.44269504f;
    bf16x8_t qf[4];
#pragma unroll
    for (int ks = 0; ks < 4; ++ks) qf[ks] = *(const bf16x8_t*)(qb + tq * 512 + h * 128 + comp * 64 + 16 * ks + 8 * hh);
    f32x16 oacc[4];
#pragma unroll
    for (int db = 0; db < 4; ++db)
#pragma unroll
        for (int i = 0; i < 16; ++i) oacc[db][i] = 0.f;
    float m = -1e30f, l = 0.f;
    const int srow = tid >> 4, sc16 = tid & 15;
    const size_t gsrc = ((size_t)b * SEQ + srow) * 512 + h * 128 + sc16 * 8;
    v4u kreg[2], vreg[2];
#define AT_LOAD(t) do { _Pragma("unroll") for (int c_ = 0; c_ < 2; ++c_) { const size_t o_ = gsrc + ((size_t)(t) * 64 + 32 * c_) * 512; kreg[c_] = *(const v4u*)(kb + o_); vreg[c_] = *(const v4u*)(vb + o_); } } while (0)
#define AT_WRITE(buf) do { _Pragma("unroll") for (int c_ = 0; c_ < 2; ++c_) { *(LAS v4u*)(lds + (buf) * AT_KBUF + (srow + 32 * c_) * AT_KP + sc16 * 16) = kreg[c_]; \
        *(LAS v4u*)(lds + AT_OFF_V + (buf) * AT_VBUF + (srow + 32 * c_) * AT_VP + sc16 * 16) = vreg[c_]; } } while (0)
    AT_LOAD(0); AT_WRITE(0);
    __syncthreads();
    const int i16 = lane & 15, q4 = i16 >> 2, p4 = i16 & 3, blk = (lane >> 4) & 1;
    const unsigned vrd = (unsigned)(size_t)(lds + AT_OFF_V) + (unsigned)((4 * hh + q4) * AT_VP + 32 * blk + 8 * p4);
    for (int t = 0; t < nt; ++t) {
        const int cur = t & 1;
        if (t + 1 < nt) AT_LOAD(t + 1);
        if (t <= cq) {
            const LAS unsigned char* Kb = lds + cur * AT_KBUF + r * AT_KP + comp * 128 + 16 * hh;
            f32x16 s0, s1;
#pragma unroll
            for (int i = 0; i < 16; ++i) { s0[i] = 0.f; s1[i] = 0.f; }
#pragma unroll
            for (int ks = 0; ks < 4; ++ks) { const bf16x8_t a0 = *(const LAS bf16x8_t*)(Kb + 32 * ks), a1 = *(const LAS bf16x8_t*)(Kb + 32 * AT_KP + 32 * ks);
                s0 = __builtin_amdgcn_mfma_f32_32x32x16_bf16(a0, qf[ks], s0, 0, 0, 0); s1 = __builtin_amdgcn_mfma_f32_32x32x16_bf16(a1, qf[ks], s1, 0, 0, 0); }
            if (cq - t <= 2) {
                const LAS float* bp = bt + (t * 64 - qpos + 192 + 4 * hh);
#pragma unroll
                for (int i = 0; i < 16; ++i) { s0[i] += bp[(i & 3) + 8 * (i >> 2)]; s1[i] += bp[32 + (i & 3) + 8 * (i >> 2)]; }
            }
            float mt = fmaxf(s0[0], s1[0]);
#pragma unroll
            for (int i = 1; i < 16; ++i) mt = fmaxf(mt, fmaxf(s0[i], s1[i]));
            mt = fmaxf(mt, __shfl_xor(mt, 32));
            const float mn = fmaxf(m, mt), alpha = __builtin_amdgcn_exp2f(m - mn); m = mn;
            float ps = 0.f;
#pragma unroll
            for (int i = 0; i < 16; ++i) { s0[i] = __builtin_amdgcn_exp2f(s0[i] - mn); s1[i] = __builtin_amdgcn_exp2f(s1[i] - mn); ps += s0[i] + s1[i]; }
            l = l * alpha + ps;
#pragma unroll
            for (int db = 0; db < 4; ++db)
#pragma unroll
                for (int i = 0; i < 16; ++i) oacc[db][i] *= alpha;
            bf16x8_t pf[2][2];
#pragma unroll
            for (int sx = 0; sx < 2; ++sx) {
                v4u w0, w1;
                w0.x = cvt2bf(s0[8 * sx + 0], s0[8 * sx + 1]); w0.y = cvt2bf(s0[8 * sx + 2], s0[8 * sx + 3]); w0.z = cvt2bf(s0[8 * sx + 4], s0[8 * sx + 5]); w0.w = cvt2bf(s0[8 * sx + 6], s0[8 * sx + 7]);
                w1.x = cvt2bf(s1[8 * sx + 0], s1[8 * sx + 1]); w1.y = cvt2bf(s1[8 * sx + 2], s1[8 * sx + 3]); w1.z = cvt2bf(s1[8 * sx + 4], s1[8 * sx + 5]); w1.w = cvt2bf(s1[8 * sx + 6], s1[8 * sx + 7]);
                pf[0][sx] = __builtin_bit_cast(bf16x8_t, w0); pf[1][sx] = __builtin_bit_cast(bf16x8_t, w1);
            }
            const unsigned va = vrd + (unsigned)(cur * AT_VBUF);
            attn_pv<0>(oacc[0], va, pf); attn_pv<1>(oacc[1], va, pf); attn_pv<2>(oacc[2], va, pf); attn_pv<3>(oacc[3], va, pf);
        }
        if (t + 1 < nt) AT_WRITE(cur ^ 1);
        __syncthreads();
    }
#undef AT_LOAD
#undef AT_WRITE
    l += __shfl_xor(l, 32);
    const float inv = 1.0f / l;
    LAS float* xch = (LAS float*)lds + (size_t)qsub * 64 * 64 + lane;
    if (comp == 1) {
        const float sc = inv * lam;
#pragma unroll
        for (int db = 0; db < 4; ++db)
#pragma unroll
            for (int i = 0; i < 16; ++i) xch[(db * 16 + i) * 64] = oacc[db][i] * sc;
    }
    __syncthreads();
    if (comp == 0) {
        float ss = 0.f;
#pragma unroll
        for (int db = 0; db < 4; ++db)
#pragma unroll
            for (int i = 0; i < 16; ++i) { const float rv = oacc[db][i] * inv - xch[(db * 16 + i) * 64]; oacc[db][i] = rv; ss += rv * rv; }
        ss += __shfl_xor(ss, 32);
        const float rr = 0.8f / sqrtf(ss * (1.0f / 128.0f) + EPS);
        bf16* orow = mix + tq * 1024 + 512 + h * 128 + 4 * hh;
#pragma unroll
        for (int db = 0; db < 4; ++db)
#pragma unroll
            for (int g4 = 0; g4 < 4; ++g4) { const int dv0 = 32 * db + 8 * g4; const f32x4 gg = *(const f32x4*)(subln_g + dv0 + 4 * hh);
                v2u w; w.x = cvt2bf(oacc[db][4 * g4 + 0] * rr * gg[0], oacc[db][4 * g4 + 1] * rr * gg[1]); w.y = cvt2bf(oacc[db][4 * g4 + 2] * rr * gg[2], oacc[db][4 * g4 + 3] * rr * gg[3]);
                *(v2u*)(orow + dv0) = w; }
    }
}

#ifndef SEL_HD
#define SEL_HD __device__ __forceinline__
#endif
#define SEL_CE_D(a, b) do { const float hi_ = fmaxf((a), (b)), lo_ = fminf((a), (b)); (a) = hi_; (b) = lo_; } while (0)
template <int N> SEL_HD void bitonic_merge_desc(float (&a)[N]) {
#pragma unroll
    for (int j = N / 2; j >= 1; j >>= 1)
#pragma unroll
        for (int i = 0; i < N; ++i) { const int l = i ^ j; if (l > i) SEL_CE_D(a[i], a[l]); }
}
template <int N> SEL_HD void bitonic_sort_desc(float (&a)[N]) {
#pragma unroll
    for (int k = 2; k <= N; k <<= 1)
#pragma unroll
        for (int j = k / 2; j >= 1; j >>= 1)
#pragma unroll
            for (int i = 0; i < N; ++i) { const int l = i ^ j; if (l > i) { if ((i & k) == 0) SEL_CE_D(a[i], a[l]); else SEL_CE_D(a[l], a[i]); } }
}
SEL_HD void merge_top16(float (&a)[16], const float (&b)[16]) {
#pragma unroll
    for (int i = 0; i < 16; ++i) a[i] = fmaxf(a[i], b[15 - i]);
    bitonic_merge_desc<16>(a);
}
SEL_HD float sel_tag(float v, unsigned mask, unsigned tag) { return __uint_as_float((__float_as_uint(v) & ~mask) | tag); }
SEL_HD void top16_of_64(float (&g)[4][16]) {
    bitonic_sort_desc<16>(g[0]); bitonic_sort_desc<16>(g[1]); bitonic_sort_desc<16>(g[2]); bitonic_sort_desc<16>(g[3]);
    merge_top16(g[0], g[1]); merge_top16(g[2], g[3]); merge_top16(g[0], g[2]);
}
SEL_HD void top16_cross(const float (&lo)[16], const float (&hi)[16], float (&t)[16]) {
#pragma unroll
    for (int i = 0; i < 16; ++i) t[i] = fmaxf(lo[i], hi[15 - i]);
    bitonic_merge_desc<16>(t);
}
SEL_HD void top16_pairs(const float (&t1)[16], const float (&t2)[16], float (&w)[16]) {
    float v1[16], v2[16];
#pragma unroll
    for (int i = 0; i < 16; ++i) { v1[i] = __uint_as_float(__float_as_uint(t1[i]) & ~127u); v2[i] = __uint_as_float(__float_as_uint(t2[i]) & ~127u); }
    const float NEG = -__builtin_inff();
#define SEL_C(i, j) sel_tag(v1[i] + v2[j], 255u, ((i) << 4) | (j))
    float g1[16], g2[16], g3[8];
#pragma unroll
    for (int j = 0; j < 16; ++j) w[j] = SEL_C(0, j);
#pragma unroll
    for (int i = 1; i < 16; ++i) g1[i - 1] = SEL_C(i, 0);
    g1[15] = NEG;
#pragma unroll
    for (int j = 1; j < 8; ++j) g2[j - 1] = SEL_C(1, j);
    g2[7] = NEG; g2[8] = NEG; g2[9] = NEG;
#pragma unroll
    for (int i = 2; i < 8; ++i) g2[17 - i] = SEL_C(i, 1);
    bitonic_merge_desc<16>(g2);
    g3[0] = SEL_C(2, 2); g3[1] = SEL_C(2, 3); g3[2] = SEL_C(2, 4); g3[3] = SEL_C(3, 2); g3[4] = SEL_C(3, 3); g3[5] = SEL_C(4, 2); g3[6] = NEG; g3[7] = NEG;
    bitonic_sort_desc<8>(g3);
#undef SEL_C
    merge_top16(w, g1);
#pragma unroll
    for (int i = 8; i < 16; ++i) g2[i] = fmaxf(g2[i], g3[15 - i]);
    bitonic_merge_desc<16>(g2);
    merge_top16(w, g2);
}
typedef _Float16 h2_t __attribute__((ext_vector_type(2)));
__device__ __forceinline__ float gelu_tanh_f(float x) {
    const float t = x * (1.0f + 0.044715f * x * x) * (-2.3022082f);
    return x * __builtin_amdgcn_rcpf(1.0f + __builtin_amdgcn_exp2f(t));
}
constexpr int SL_KP = 272, SL_KBUF = 128 * SL_KP, SL_OFF_TAB = 2 * SL_KBUF;
static_assert(SL_OFF_TAB + 8 * 2048 <= RING_BYTES, "selection LDS map");
__device__ __forceinline__ void peer_half_top16(const LAS unsigned char* Kb, const bf16* qrow, int hh, float (&Tc)[16]) {
    bf16x8_t qf[8];
#pragma unroll
    for (int ks = 0; ks < 8; ++ks) qf[ks] = *(const bf16x8_t*)(qrow + 16 * ks + 8 * hh);
    float g[4][16];
#pragma unroll
    for (int nb = 0; nb < 4; ++nb) {
        f32x16 sacc;
#pragma unroll
        for (int i = 0; i < 16; ++i) sacc[i] = 0.f;
#pragma unroll
        for (int ks = 0; ks < 8; ++ks) { const bf16x8_t a = *(const LAS bf16x8_t*)(Kb + nb * 32 * SL_KP + 32 * ks); sacc = __builtin_amdgcn_mfma_f32_32x32x16_bf16(a, qf[ks], sacc, 0, 0, 0); }
#pragma unroll
        for (int i = 0; i < 16; ++i) g[nb][i] = __uint_as_float((__float_as_uint(sacc[i]) & ~127u) | (unsigned)(32 * nb + (i & 3) + 8 * (i >> 2) + 4 * hh));
    }
    top16_of_64(g);
    float lo[16], hi[16];
#pragma unroll
    for (int i = 0; i < 16; ++i) { const unsigned x = __float_as_uint(g[0][i]); auto rr = __builtin_amdgcn_permlane32_swap(x, x, false, false); lo[i] = __uint_as_float(rr[0]); hi[i] = __uint_as_float(rr[1]); }
    top16_cross(lo, hi, Tc);
}
__device__ __forceinline__ void peer_select_unit(LAS unsigned char* lds, int tg, int h, const bf16* pq, const float* part2, const bf16* keysb, unsigned* sel_raw, int tid, int lane, int wave) {
    const int r = lane & 31, hh = lane >> 5;
    __syncthreads();
    {
        const bf16* src = keysb + (size_t)h * 2 * 128 * 128;
        v4u kr[8];
#pragma unroll
        for (int i = 0; i < 8; ++i) { const int ch = tid + 512 * i; kr[i] = *(const v4u*)(src + (size_t)ch * 8); }
#pragma unroll
        for (int i = 0; i < 8; ++i) { const int ch = tid + 512 * i, row = ch >> 4, c16 = ch & 15; *(LAS v4u*)(lds + row * SL_KP + c16 * 16) = kr[i]; }
    }
    __syncthreads();
    const int t = tg * 256 + wave * 32 + r;
    float rs2;
    { const f32x4* pp = (const f32x4*)(part2 + (size_t)t * 16); const f32x4 a = pp[0], b = pp[1], c = pp[2], d = pp[3];
      const float ss = ((a[0] + a[1]) + (a[2] + a[3])) + ((b[0] + b[1]) + (b[2] + b[3])) + ((c[0] + c[1]) + (c[2] + c[3])) + ((d[0] + d[1]) + (d[2] + d[3]));
      rs2 = 1.0f / sqrtf(ss * (1.0f / 1024.0f) + EPS); }
    float T0[16], T1[16];
    peer_half_top16(lds + 0 * SL_KBUF + r * SL_KP + 16 * hh, pq + (size_t)t * 2048 + h * 256, hh, T0);
    peer_half_top16(lds + 1 * SL_KBUF + r * SL_KP + 16 * hh, pq + (size_t)t * 2048 + h * 256 + 128, hh, T1);
    float W[16];
    top16_pairs(T0, T1, W);
    LAS unsigned char* tab = lds + SL_OFF_TAB + wave * 2048 + lane;
#pragma unroll
    for (int i = 0; i < 16; ++i) { tab[i * 64] = (unsigned char)(__float_as_uint(T0[i]) & 127u); tab[(16 + i) * 64] = (unsigned char)(__float_as_uint(T1[i]) & 127u); }
    float ex[16]; float sum = 0.f;
    const float sc = rs2 * 1.44269504f, v0 = __uint_as_float(__float_as_uint(W[0]) & ~255u);
#pragma unroll
    for (int k = 0; k < 16; ++k) { const float vk = __uint_as_float(__float_as_uint(W[k]) & ~255u); ex[k] = __builtin_amdgcn_exp2f((vk - v0) * sc); sum += ex[k]; }
    const float isum = 262144.0f / sum;
    LDS_WAIT(); asm volatile("" ::: "memory");
#pragma unroll
    for (int k = 0; k < 16; ++k) {
        const unsigned w = __float_as_uint(W[k]);
        const unsigned n1 = tab[((w >> 4) & 15u) * 64], n2 = tab[(16u + (w & 15u)) * 64];
        unsigned q = (unsigned)(ex[k] * isum + 0.5f); q = q > 262143u ? 262143u : q;
        if ((k >> 3) == hh) sel_raw[(size_t)t * 128 + h * 16 + k] = ((n1 * 128u + n2) << 18) | q;
    }
}

constexpr int SW_SEL_BYTES = 64 * 512;
__device__ __forceinline__ void peer_sweep_block(LAS unsigned char* lds, int tok0, const unsigned* sel_raw, const float* part2, const _Float16* utab, const _Float16* vtab, const float* g_ffn, float* hio, bf16* hb, float* rs3, int lane, int wave) {
    LAS unsigned* sel = (LAS unsigned*)lds + wave * 8 * 128;
#pragma unroll 1
    for (int tt = 0; tt < 8; ++tt) {
        const unsigned* src = sel_raw + (size_t)(tok0 + wave * 8 + tt) * 128;
        unsigned a0 = src[lane], a1 = src[64 + lane];
#pragma unroll
        for (int k = 2; k <= 128; k <<= 1)
#pragma unroll
            for (int j = k >> 1; j >= 1; j >>= 1) {
                if (j == 64) { const unsigned mn = a0 < a1 ? a0 : a1, mx = a0 < a1 ? a1 : a0; a0 = mn; a1 = mx; }
                else {
                    const unsigned o0 = __shfl_xor(a0, j), o1 = __shfl_xor(a1, j);
                    const bool lower = (lane & j) == 0;
                    const bool up0 = (k >= 128) ? true : ((lane & k) == 0);
                    const bool up1 = (k >= 128) ? true : (k == 64 ? false : ((lane & k) == 0));
                    const unsigned mn0 = a0 < o0 ? a0 : o0, mx0 = a0 < o0 ? o0 : a0, mn1 = a1 < o1 ? a1 : o1, mx1 = a1 < o1 ? o1 : a1;
                    a0 = (up0 == lower) ? mn0 : mx0; a1 = (up1 == lower) ? mn1 : mx1;
                }
            }
        sel[tt * 128 + lane] = a0; sel[tt * 128 + 64 + lane] = a1;
    }
    LDS_WAIT(); asm volatile("" ::: "memory");
#pragma unroll 1
    for (int pp = 0; pp < 2; ++pp) {
        h2_t xn[4][8]; float acc[4][16]; int ptr[4];
#pragma unroll
        for (int tt = 0; tt < 4; ++tt) {
            const int t = tok0 + wave * 8 + pp * 4 + tt;
            float ps = lane < 16 ? part2[(size_t)t * 16 + lane] : 0.f; ps = wave_sum(ps);
            const float rs2 = 1.0f / sqrtf(ps * (1.0f / 1024.0f) + EPS);
#pragma unroll
            for (int j = 0; j < 2; ++j) { const float* hp = hio + (size_t)t * 1024 + 512 * j + 8 * lane; const float* gp = g_ffn + 512 * j + 8 * lane;
                const f32x4 a = *(const f32x4*)hp, b = *(const f32x4*)(hp + 4), ga = *(const f32x4*)gp, gb = *(const f32x4*)(gp + 4);
                xn[tt][4 * j + 0] = (h2_t){(_Float16)(a[0] * rs2 * ga[0]), (_Float16)(a[1] * rs2 * ga[1])}; xn[tt][4 * j + 1] = (h2_t){(_Float16)(a[2] * rs2 * ga[2]), (_Float16)(a[3] * rs2 * ga[3])};
                xn[tt][4 * j + 2] = (h2_t){(_Float16)(b[0] * rs2 * gb[0]), (_Float16)(b[1] * rs2 * gb[1])}; xn[tt][4 * j + 3] = (h2_t){(_Float16)(b[2] * rs2 * gb[2]), (_Float16)(b[3] * rs2 * gb[3])}; }
#pragma unroll
            for (int i = 0; i < 16; ++i) acc[tt][i] = 0.f;
            ptr[tt] = 0;
        }
#pragma unroll 1
        for (int rnd = 0; rnd < 32; ++rnd) {
            const unsigned lim = ((unsigned)(rnd + 1) << 27) - 1u;
#pragma unroll
            for (int tt = 0; tt < 4; ++tt) {
                const LAS unsigned* sl = sel + (pp * 4 + tt) * 128;
                while (ptr[tt] < 128) {
                    const v4u kk = *(const LAS v4u*)(sl + ptr[tt]);
                    const unsigned k0 = __builtin_amdgcn_readfirstlane(kk[0]);
                    if (k0 > lim) break;
                    const unsigned ks[4] = {k0, (unsigned)__builtin_amdgcn_readfirstlane(kk[1]), (unsigned)__builtin_amdgcn_readfirstlane(kk[2]), (unsigned)__builtin_amdgcn_readfirstlane(kk[3])};
                    v4u U[4][2], V[4][2];
#pragma unroll
                    for (int s = 0; s < 4; ++s) { const size_t ro = (size_t)(ks[s] >> 18) * 1024 + 8 * lane;
#pragma unroll
                        for (int j = 0; j < 2; ++j) { U[s][j] = *(const v4u*)(utab + ro + 512 * j); V[s][j] = *(const v4u*)(vtab + ro + 512 * j); } }
                    float d[4];
#pragma unroll
                    for (int s = 0; s < 4; ++s) { float dd = 0.f;
#pragma unroll
                        for (int j = 0; j < 2; ++j)
#pragma unroll
                            for (int q = 0; q < 4; ++q) { const unsigned uw = U[s][j][q]; dd = __builtin_amdgcn_fdot2(__builtin_bit_cast(h2_t, uw), xn[tt][4 * j + q], dd, false); }
                        d[s] = dd; }
                    const bool b0 = lane & 1, b1 = lane & 2;
                    float t0 = b0 ? d[1] : d[0], o0 = b0 ? d[0] : d[1]; t0 += __shfl_xor(o0, 1);
                    float t1 = b0 ? d[3] : d[2], o1 = b0 ? d[2] : d[3]; t1 += __shfl_xor(o1, 1);
                    float tu = b1 ? t1 : t0, ou = b1 ? t0 : t1; tu += __shfl_xor(ou, 2);
                    tu += __shfl_xor(tu, 4); tu += __shfl_xor(tu, 8); tu += __shfl_xor(tu, 16); tu += __shfl_xor(tu, 32);
                    const float act = gelu_tanh_f(tu);
#pragma unroll
                    for (int s = 0; s < 4; ++s) { const float cf = __uint_as_float(__builtin_amdgcn_readlane(__float_as_uint(act), s)) * ((float)(ks[s] & 0x3ffffu) * (1.0f / 262144.0f));
#pragma unroll
                        for (int j = 0; j < 2; ++j)
#pragma unroll
                            for (int q = 0; q < 4; ++q) { const unsigned vw = V[s][j][q]; const h2_t vv = __builtin_bit_cast(h2_t, vw); acc[tt][8 * j + 2 * q] += cf * (float)vv[0]; acc[tt][8 * j + 2 * q + 1] += cf * (float)vv[1]; } }
                    ptr[tt] += 4;
                }
            }
        }
#pragma unroll
        for (int tt = 0; tt < 4; ++tt) {
            const int t = tok0 + wave * 8 + pp * 4 + tt; float ss = 0.f;
#pragma unroll
            for (int j = 0; j < 2; ++j) { float* hp = hio + (size_t)t * 1024 + 512 * j + 8 * lane; f32x4 a = *(const f32x4*)hp, b = *(const f32x4*)(hp + 4);
#pragma unroll
                for (int e = 0; e < 4; ++e) { a[e] += acc[tt][8 * j + e]; b[e] += acc[tt][8 * j + 4 + e]; }
                *(f32x4*)hp = a; *(f32x4*)(hp + 4) = b; ss += dot4(a, a) + dot4(b, b);
                v4u w; w.x = pk2(a[0], a[1]); w.y = pk2(a[2], a[3]); w.z = pk2(b[0], b[1]); w.w = pk2(b[2], b[3]); *(v4u*)(hb + (size_t)t * 1024 + 512 * j + 8 * lane) = w; }
            ss = wave_sum(ss);
            if (lane == 0) rs3[t] = 1.0f / sqrtf(ss * (1.0f / 1024.0f) + EPS);
        }
    }
}


__device__ __forceinline__ void peer_apply_naive(int t, int lane, const unsigned* sel_raw, const float* part2, const float* u_tab, const float* v_tab, const float* g_ffn, float* hio, bf16* hb, float* rs3) {
    float ps = lane < 16 ? part2[(size_t)t * 16 + lane] : 0.f; ps = wave_sum(ps);
    const float rs2 = 1.0f / sqrtf(ps * (1.0f / 1024.0f) + EPS);
    f32x4 hv[4], xn[4], acc[4];
#pragma unroll
    for (int j = 0; j < 4; ++j) { hv[j] = *(const f32x4*)(hio + (size_t)t * 1024 + 256 * j + 4 * lane); const f32x4 gv = *(const f32x4*)(g_ffn + 256 * j + 4 * lane); xn[j] = hv[j] * rs2 * gv; acc[j] = (f32x4){0.f, 0.f, 0.f, 0.f}; }
#pragma unroll 2
    for (int sidx = 0; sidx < 128; ++sidx) {
        const unsigned key = sel_raw[(size_t)t * 128 + sidx]; const int e = key >> 18; const float g = (float)(key & 0x3ffffu) * (1.0f / 262144.0f);
        const f32x4* ur = (const f32x4*)(u_tab + (size_t)e * 1024) + lane; const f32x4* vr = (const f32x4*)(v_tab + (size_t)e * 1024) + lane;
        float d = 0.f;
#pragma unroll
        for (int j = 0; j < 4; ++j) d += dot4(ur[64 * j], xn[j]);
        d = wave_sum(d);
        const float coef = g * gelu_tanh_f(d);
#pragma unroll
        for (int j = 0; j < 4; ++j) acc[j] += coef * vr[64 * j];
    }
    float ss = 0.f;
#pragma unroll
    for (int j = 0; j < 4; ++j) { const f32x4 h2 = hv[j] + acc[j]; *(f32x4*)(hio + (size_t)t * 1024 + 256 * j + 4 * lane) = h2; ss += dot4(h2, h2);
        v2u w; w.x = pk2(h2[0], h2[1]); w.y = pk2(h2[2], h2[3]); *(v2u*)(hb + (size_t)t * 1024 + 256 * j + 4 * lane) = w; }
    ss = wave_sum(ss);
    if (lane == 0) rs3[t] = 1.0f / sqrtf(ss * (1.0f / 1024.0f) + EPS);
}
struct Args { const float* in[25]; float* out; unsigned char* ws; int ph_lo, ph_hi; };

#define AS4 __attribute__((address_space(4)))
#define KARGS_HERE const Args AS4* ap = (const Args AS4*)__builtin_amdgcn_kernarg_segment_ptr(); asm volatile("" : "+s"(ap))
__global__ void __launch_bounds__(NWAVES * 64, 2) fwd(Args args) {
    extern __shared__ __attribute__((aligned(16))) unsigned char lds_raw[];
    LAS unsigned char* lds = (LAS unsigned char*)lds_raw;
    volatile LAS unsigned* MISC = (volatile LAS unsigned*)(lds + MISC_OFF);
    const int tid = threadIdx.x, lane = tid & 63, wave = __builtin_amdgcn_readfirstlane(tid >> 6);
    const int G = gridDim.x, bid = blockIdx.x;
    unsigned char* ws = args.ws;
    if (tid < 32) MISC[tid] = 0u;
    __syncthreads();
    XcdBarrier bar; bar.bar = (unsigned*)(ws + WS_CTL); bar.x = 0; bar.st = nullptr;
    if (N_LAUNCHES == 1) bar = xcd_barrier_post((unsigned*)(ws + WS_CTL), MISC + 8);
#define GRID_BAR() do { if (N_LAUNCHES == 1) xcd_barrier(bar); } while (0)
    const int lo = args.ph_lo, hi = args.ph_hi;
#ifdef ONLY_PHASE
#define IN(k) ((k) == ONLY_PHASE)
#else
#define IN(k) (lo <= (k) && (k) < hi)
#endif
#define IN_X       (ap->in[0])
#define IN_P       (ap->in[1])
#define IN_GMIX    (ap->in[2])
#define IN_WIN     (ap->in[3])
#define IN_LNG     (ap->in[4])
#define IN_LNB     (ap->in[5])
#define IN_WS      (ap->in[6])
#define IN_BS      (ap->in[7])
#define IN_BETA    (ap->in[8])
#define IN_LQ1     (ap->in[9])
#define IN_LK1     (ap->in[10])
#define IN_LQ2     (ap->in[11])
#define IN_LK2     (ap->in[12])
#define IN_SUBLN   (ap->in[13])
#define IN_RELB    (ap->in[14])
#define IN_WOUT    (ap->in[15])
#define IN_GFFN    (ap->in[16])
#define IN_WQ      (ap->in[17])
#define IN_KEYS    (ap->in[18])
#define IN_UTAB    (ap->in[19])
#define IN_VTAB    (ap->in[20])
#define IN_GPLE    (ap->in[21])
#define IN_WPLE    (ap->in[22])
#define IN_WGATE   (ap->in[23])
#define IN_GFINAL  (ap->in[24])
#define OUTP       (ap->out)
#define Win_t   ((bf16*)(ws + WS_WIN))
#define Wout_t  ((bf16*)(ws + WS_WOUT))
#define Wq_t    ((bf16*)(ws + WS_WQ))
#define Wgate_t ((bf16*)(ws + WS_WGATE))
#define Wple_t  ((bf16*)(ws + WS_WPLE))
#define rs1     ((float*)(ws + WS_RS1))
#define rs3     ((float*)(ws + WS_RS3))
#define part4   ((float*)(ws + WS_PART4))
#define part2   ((float*)(ws + WS_PART2))
#define Abuf    ((bf16*)(ws + WS_A))
#define pb      ((bf16*)(ws + WS_PB))
#define pleb    ((bf16*)(ws + WS_PLE))
#define mix     ((bf16*)(ws + WS_M))
#define pq      ((bf16*)(ws + WS_M))
#define vbuf    ((bf16*)(ws + WS_F))
#define keysb   ((bf16*)(ws + WS_KEYSB))
#define utabh   ((_Float16*)(ws + WS_TAB))
#define vtabh   ((_Float16*)(ws + WS_TAB + 32 * MiB))
#define selraw  ((unsigned*)(ws + WS_SEL))
#define zA      ((bf16*)ap->out)
#define qbuf    ((bf16*)((unsigned char*)ap->out + 32 * MiB))
#define kbuf    ((bf16*)((unsigned char*)ap->out + 48 * MiB))
    const int gw = bid * NWAVES + wave, NGW = G * NWAVES;

    if (IN(0)) { KARGS_HERE;
        LAS float* scr = (LAS float*)(lds + wave * 16384);
        constexpr int I_IN = 16 * 80, I_OUT = 16 * 32, I_Q = 16 * 64, I_G = 16 * 32, I_P = 4 * 32;
        for (int it = gw; it < I_IN + I_OUT + I_Q + I_G + I_P; it += NGW) {
            int r = it;
            if (r < I_IN) { p0_transpose_item(IN_WIN, IN_GMIX, 1024, 2560, Win_t, scr, r, lane); continue; } r -= I_IN;
            if (r < I_OUT) { p0_transpose_item(IN_WOUT, nullptr, 1024, 1024, Wout_t, scr, r, lane); continue; } r -= I_OUT;
            if (r < I_Q) { p0_transpose_item(IN_WQ, IN_GFFN, 1024, 2048, Wq_t, scr, r, lane); continue; } r -= I_Q;
            if (r < I_G) { p0_transpose_item(IN_WGATE, IN_GPLE, 1024, 1024, Wgate_t, scr, r, lane); continue; } r -= I_G;
            p0_transpose_item(IN_WPLE, nullptr, 256, 1024, Wple_t, scr, r, lane);
        }
        for (int m = gw; m < T; m += NGW) {
            const f32x4* xr = (const f32x4*)(IN_X + (size_t)m * D) + lane; f32x4 v[4]; float s = 0.f;
#pragma unroll
            for (int j = 0; j < 4; ++j) { v[j] = xr[64 * j]; s += dot4(v[j], v[j]); }
            s = wave_sum(s);
            if (lane == 0) rs1[m] = 1.0f / sqrtf(s * (1.0f / 1024.0f) + EPS);
            v2u* o = (v2u*)(Abuf + (size_t)m * D) + lane;
#pragma unroll
            for (int j = 0; j < 4; ++j) { v2u w; w.x = pk2(v[j][0], v[j][1]); w.y = pk2(v[j][2], v[j][3]); o[64 * j] = w; }
            const f32x4 pv = *((const f32x4*)(IN_P + (size_t)m * 256) + lane); v2u w; w.x = pk2(pv[0], pv[1]); w.y = pk2(pv[2], pv[3]); *((v2u*)(pb + (size_t)m * 256) + lane) = w;
        }
        {
            const size_t gt = (size_t)bid * (NWAVES * 64) + tid, GT = (size_t)G * (NWAVES * 64);
            for (size_t i = gt; i < (size_t)(8 * 2 * 128 * 128 / 8); i += GT) { const f32x4 a = *((const f32x4*)IN_KEYS + 2 * i), b = *((const f32x4*)IN_KEYS + 2 * i + 1);
                v4u w; w.x = pk2(a[0], a[1]); w.y = pk2(a[2], a[3]); w.z = pk2(b[0], b[1]); w.w = pk2(b[2], b[3]); *((v4u*)keysb + i) = w; }
            typedef _Float16 h8_t __attribute__((ext_vector_type(8)));
            for (size_t i = gt; i < (size_t)16384 * 1024 / 8; i += GT) {
                const f32x4 a = *((const f32x4*)IN_UTAB + 2 * i), b = *((const f32x4*)IN_UTAB + 2 * i + 1), c = *((const f32x4*)IN_VTAB + 2 * i), d = *((const f32x4*)IN_VTAB + 2 * i + 1);
                h8_t hu, hv;
#pragma unroll
                for (int e = 0; e < 4; ++e) { hu[e] = (_Float16)a[e]; hu[4 + e] = (_Float16)b[e]; hv[e] = (_Float16)c[e]; hv[4 + e] = (_Float16)d[e]; }
                *((h8_t*)utabh + i) = hu; *((h8_t*)vtabh + i) = hv; }
        }
        if (IN(1)) GRID_BAR();
    }
    if (IN(1)) { KARGS_HERE;
        { pg8::Gemm g{Abuf, Win_t, T, 2560, 1024}; pg8::StaticOrder S; S.init(T, 2560, G, bid);
          pg8::EpiZ E{zA, qbuf, kbuf, vbuf, rs1, 0.125f * 1.44269504f};
          pg8::gemm_phase<pg8::EpiZ, pg8::StaticOrder, true, true>(lds, g, S, E); }
        { pg8::Gemm g{pb, Wple_t, T, 1024, 256}; pg8::StaticOrder S; S.init(T, 1024, G, bid);
          pg8::EpiBf E{pleb, 1024};
          pg8::gemm_phase<pg8::EpiBf, pg8::StaticOrder, true, true>(lds, g, S, E); }
        if (IN(2)) GRID_BAR();
    }
    if (IN(2)) { KARGS_HERE;
#ifdef PROBE_P2_TWICE
        for (int rep = 0; rep < 2; ++rep) {
#endif
        for (int u = bid; u < 512; u += G) gmlp_unit(lds, u >> 2, u & 3, zA, IN_LNG, IN_LNB, IN_WS, IN_BS, IN_BETA, mix, tid);
        float lam;
        { const float a = IN_LQ1[lane] * IN_LK1[lane], b2 = IN_LQ2[lane] * IN_LK2[lane]; lam = __expf(wave_sum(a)) - __expf(wave_sum(b2)) + 0.2f; }
        for (int i = 0; i < 2; ++i) { const int u = i * G + bid; if (u >= 512) break;
            const int bh = u & 15, jp = (u >> 4) & 15, jb = (u < 256) ? 31 - jp : jp;
            attn_unit(lds, bh >> 2, bh & 3, jb, qbuf, kbuf, vbuf, IN_RELB, lam, IN_SUBLN, mix, tid, lane, wave); }
#ifdef PROBE_P2_TWICE
        }
#endif
        if (IN(3)) GRID_BAR();
    }
    if (IN(3)) { KARGS_HERE;
        pg8::Gemm g{mix, Wout_t, T, 1024, 1024}; pg8::StaticOrder S; S.init(T, 1024, G, bid);
        pg8::EpiRes E{IN_X, OUTP, Abuf, part2};
        pg8::gemm_phase<pg8::EpiRes, pg8::StaticOrder, true, true>(lds, g, S, E);
        if (IN(4)) GRID_BAR();
    }
    if (IN(4)) { KARGS_HERE;
        pg8::Gemm g{Abuf, Wq_t, T, 2048, 1024}; pg8::StaticOrder S; S.init(T, 2048, G, bid);
        pg8::EpiBf E{pq, 2048};
        pg8::gemm_phase<pg8::EpiBf, pg8::StaticOrder, true, true>(lds, g, S, E);
        if (IN(5)) GRID_BAR();
    }
    if (IN(5)) { KARGS_HERE;
        for (int u = bid; u < 512; u += G) peer_select_unit(lds, u >> 3, u & 7, pq, part2, keysb, selraw, tid, lane, wave);
        if (IN(6)) GRID_BAR();
    }
    if (IN(6)) { KARGS_HERE;
#ifdef DBG_NAIVE_APPLY
        for (int t = gw; t < T; t += NGW) peer_apply_naive(t, lane, selraw, part2, IN_UTAB, IN_VTAB, IN_GFFN, OUTP, Abuf, rs3);
#else
        for (int tb = bid; tb < T / 64; tb += G) { __syncthreads(); peer_sweep_block(lds, tb * 64, selraw, part2, utabh, vtabh, IN_GFFN, OUTP, Abuf, rs3, lane, wave); }
#endif
        if (IN(7)) GRID_BAR();
    }
    if (IN(7)) { KARGS_HERE;
        pg8::Gemm g{Abuf, Wgate_t, T, 1024, 1024}; pg8::StaticOrder S; S.init(T, 1024, G, bid);
        pg8::EpiGate E{OUTP, pleb, rs3, part4};
        pg8::gemm_phase<pg8::EpiGate, pg8::StaticOrder, true, true>(lds, g, S, E);
        if (IN(8)) GRID_BAR();
    }
    if (IN(8)) { KARGS_HERE;
        for (int m = gw; m < T; m += NGW) {
            float ps = lane < 16 ? part4[(size_t)m * 16 + lane] : 0.f; ps = wave_sum(ps);
            const float r = 1.0f / sqrtf(ps * (1.0f / 1024.0f) + EPS);
            f32x4* hr = (f32x4*)(OUTP + (size_t)m * D) + lane;
#pragma unroll
            for (int j = 0; j < 4; ++j) { const f32x4 gv = *((const f32x4*)IN_GFINAL + 64 * j + lane); hr[64 * j] = hr[64 * j] * r * gv; }
        }
    }
#undef IN
#undef GRID_BAR
}

extern "C" void kernel_launch(void* const* d_in, const int* in_sizes, int n_in, void* d_out, int out_size, void* d_ws, size_t ws_size, hipStream_t stream) {
    static int grid = 0;
    if (grid == 0) {
        if (n_in != 25 || out_size != T * D || ws_size < WS_END) { fprintf(stderr, "kernel_launch: unexpected shapes (n_in %d, out %d, ws %zu)\n", n_in, out_size, ws_size); grid = -1; return; }
        int dev = 0, cus = 0, per_cu = 0;
        if (hipGetDevice(&dev) != hipSuccess || hipDeviceGetAttribute(&cus, hipDeviceAttributeMultiprocessorCount, dev) != hipSuccess) { grid = -1; return; }
        if (hipFuncSetAttribute((const void*)fwd, hipFuncAttributeMaxDynamicSharedMemorySize, LDS_BYTES) != hipSuccess) { fprintf(stderr, "kernel_launch: hipFuncSetAttribute failed\n"); grid = -1; return; }
        if (hipOccupancyMaxActiveBlocksPerMultiprocessor(&per_cu, (const void*)fwd, NWAVES * 64, LDS_BYTES) != hipSuccess || per_cu < 1) { fprintf(stderr, "kernel_launch: occupancy query says %d blocks per CU\n", per_cu); }
        (void)hipGetLastError();
        grid = cus;
    }
    if (grid < 0) return;
    if (N_LAUNCHES == 1) (void)hipMemsetAsync((char*)d_ws + WS_CTL, 0, CTL_ZERO_BYTES, stream);
    Args a{};
    for (int i = 0; i < 25; ++i) a.in[i] = (const float*)d_in[i];
    a.out = (float*)d_out; a.ws = (unsigned char*)d_ws;
    if (N_LAUNCHES == 1) { a.ph_lo = 0; a.ph_hi = NPHASE; hipLaunchKernelGGL(fwd, dim3(grid), dim3(NWAVES * 64), LDS_BYTES, stream, a); }
    else for (int li = 0; li < NPHASE; ++li) { a.ph_lo = li; a.ph_hi = li + 1; hipLaunchKernelGGL(fwd, dim3(grid), dim3(NWAVES * 64), LDS_BYTES, stream, a); }
}
```

```cpp
#include <hip/hip_runtime.h>
#include <cstdio>
#include <cstdint>
namespace pg8 {
#define PG8_LAS __attribute__((address_space(3)))
typedef unsigned short bf16_t;
typedef short bf16x8 __attribute__((ext_vector_type(8)));
typedef float f32x4 __attribute__((ext_vector_type(4)));
typedef unsigned u32x4 __attribute__((ext_vector_type(4)));
constexpr int BM = 256, BK = 64, HALF = 128, HTB = HALF * BK * 2  , STAGE_BYTES = 8 * HTB, NXCD = 8, WGM = 8;

__host__ __device__ __forceinline__ int lds_byte(int r, int c) { const int st = (r >> 4) * 2 + (c >> 5), rr = r & 15, cc = c & 31, ob = rr * 64 + cc * 2; return st * 1024 + (ob ^ (((ob >> 9) & 1) << 5)); }
__host__ __device__ __forceinline__ void stage_rc(int b, int& R, int& C) { const int st = b / 1024, sb = b % 1024, swz = sb ^ (((sb >> 9) & 1) << 5); R = (st >> 1) * 16 + swz / 64; C = (st & 1) * 32 + (swz % 64) / 2; }
__host__ __device__ __forceinline__ int perm32(int rho) { const int n = rho >> 4, i = rho & 15; return 8 * (i >> 2) + 4 * n + (i & 3); }

struct Unit { int pm, pn; };
struct Gemm { const bf16_t* A; const bf16_t* Bt; int M, N, K; };

struct StaticOrder {
    int nM, nN, nwg, G, c;
    __host__ __device__ void init(int M, int N, int G_, int c_) { nM = M / BM; nN = N / BM; nwg = nM * nN; G = G_; c = c_; }
    __host__ __device__ bool next(int i, Unit& u) const {
        const long L = (long)i * G + c; if (L >= nwg) return false;
        int wgid = (int)L; { const int q = nwg / NXCD, r = nwg % NXCD, xcd = wgid % NXCD, off = wgid / NXCD; wgid = (xcd < r ? xcd * (q + 1) : r * (q + 1) + (xcd - r) * q) + off; }
        const int nig = WGM * nN, gid = wgid / nig, fm = gid * WGM, gsz = (nM - fm) < WGM ? (nM - fm) : WGM;
        u.pm = fm + ((wgid % nig) % gsz); u.pn = (wgid % nig) / gsz; return true;
    }
    __device__ __forceinline__ void a_ready(const Unit&) const {}
    __device__ __forceinline__ void done(const Unit&) const {}
};


__device__ __forceinline__ unsigned cvt_pk_bf16(float lo, float hi) { unsigned r; asm volatile("v_cvt_pk_bf16_f32 %0, %1, %2" : "=v"(r) : "v"(lo), "v"(hi)); return r; }
typedef unsigned u32x2 __attribute__((ext_vector_type(2)));
__device__ __forceinline__ float gelu_tanh(float x) {
    const float t = x * (1.0f + 0.044715f * x * x) * (-2.3022082f);
    return x * __builtin_amdgcn_rcpf(1.0f + __builtin_amdgcn_exp2f(t));
}
__device__ __forceinline__ float bf_lo(unsigned w) { return __uint_as_float(w << 16); }
__device__ __forceinline__ float bf_hi(unsigned w) { return __uint_as_float(w & 0xffff0000u); }

struct EpiZ {
    static constexpr bool PERM = true, AFTER_DRAIN = false;
    bf16_t *zA, *q, *k, *v; const float* rs; float qscale;
    __device__ __forceinline__ void operator()(const f32x4 (&acc)[2][2][4][2], const Unit& u, int wr, int wc, int fr, int fq) const {
        const int pn = u.pn; bf16_t* base; int ldc, colt; float sc = 1.f; bool act = false;
        if (pn < 4) { base = zA; ldc = 1024; colt = pn * BM; act = true; }
        else if (pn < 6) { base = q; ldc = 512; colt = (pn - 4) * BM; sc = qscale; }
        else if (pn < 8) { base = k; ldc = 512; colt = (pn - 6) * BM; }
        else { base = v; ldc = 512; colt = (pn - 8) * BM; }
        const int row0 = u.pm * BM + wr * 64 + fr, col0 = colt + wc * 32 + 8 * fq;
#pragma unroll
        for (int ai = 0; ai < 2; ++ai)
#pragma unroll
            for (int m = 0; m < 4; ++m) { const int r = row0 + ai * HALF + m * 16; const float s = rs[r] * sc; bf16_t* rowp = base + (size_t)r * ldc + col0;
#pragma unroll
                for (int bj = 0; bj < 2; ++bj) { f32x4 v0 = acc[ai][bj][m][0] * s, v1 = acc[ai][bj][m][1] * s;
                    if (act) {
#pragma unroll
                        for (int j = 0; j < 4; ++j) { v0[j] = gelu_tanh(v0[j]); v1[j] = gelu_tanh(v1[j]); } }
                    u32x4 w; w.x = cvt_pk_bf16(v0[0], v0[1]); w.y = cvt_pk_bf16(v0[2], v0[3]); w.z = cvt_pk_bf16(v1[0], v1[1]); w.w = cvt_pk_bf16(v1[2], v1[3]);
                    *(u32x4*)(rowp + bj * HALF) = w; }
                asm volatile("" ::: "memory"); }
    }
};
struct EpiBf {
    static constexpr bool PERM = true, AFTER_DRAIN = false;
    bf16_t* O; int ldc;
    __device__ __forceinline__ void operator()(const f32x4 (&acc)[2][2][4][2], const Unit& u, int wr, int wc, int fr, int fq) const {
        const int row0 = u.pm * BM + wr * 64 + fr, col0 = u.pn * BM + wc * 32 + 8 * fq;
#pragma unroll
        for (int ai = 0; ai < 2; ++ai)
#pragma unroll
            for (int m = 0; m < 4; ++m) { bf16_t* rowp = O + (size_t)(row0 + ai * HALF + m * 16) * ldc + col0;
#pragma unroll
                for (int bj = 0; bj < 2; ++bj) { const f32x4 v0 = acc[ai][bj][m][0], v1 = acc[ai][bj][m][1];
                    u32x4 w; w.x = cvt_pk_bf16(v0[0], v0[1]); w.y = cvt_pk_bf16(v0[2], v0[3]); w.z = cvt_pk_bf16(v1[0], v1[1]); w.w = cvt_pk_bf16(v1[2], v1[3]);
                    *(u32x4*)(rowp + bj * HALF) = w; } }
    }
};
struct EpiRes {
    static constexpr bool PERM = false, AFTER_DRAIN = false;
    const float* base; float* out; bf16_t* hb; float* part;
    __device__ __forceinline__ void operator()(const f32x4 (&acc)[2][2][4][2], const Unit& u, int wr, int wc, int fr, int fq) const {
        const int row0 = u.pm * BM + wr * 64 + fr, col0 = u.pn * BM + wc * 32 + 4 * fq;
#pragma unroll
        for (int ai = 0; ai < 2; ++ai)
#pragma unroll
            for (int m = 0; m < 4; ++m) { const int r = row0 + ai * HALF + m * 16; const size_t off = (size_t)r * 1024 + col0; float ss = 0.f;
#pragma unroll
                for (int bj = 0; bj < 2; ++bj)
#pragma unroll
                    for (int n = 0; n < 2; ++n) { const size_t o = off + bj * HALF + n * 16; const f32x4 b = *(const f32x4*)(base + o); const f32x4 h = b + acc[ai][bj][m][n];
                        *(f32x4*)(out + o) = h; ss += (h[0] * h[0] + h[1] * h[1]) + (h[2] * h[2] + h[3] * h[3]);
                        u32x2 w; w.x = cvt_pk_bf16(h[0], h[1]); w.y = cvt_pk_bf16(h[2], h[3]); *(u32x2*)(hb + o) = w; }
                ss += __shfl_xor(ss, 16); ss += __shfl_xor(ss, 32);
                if (fq == 0) part[(size_t)r * 16 + u.pn * 4 + wc] = ss; }
    }
};
struct EpiGate {
    static constexpr bool PERM = false, AFTER_DRAIN = false;
    float* hio; const bf16_t* ple; const float* rs; float* part;
    __device__ __forceinline__ void operator()(const f32x4 (&acc)[2][2][4][2], const Unit& u, int wr, int wc, int fr, int fq) const {
        const int row0 = u.pm * BM + wr * 64 + fr, col0 = u.pn * BM + wc * 32 + 4 * fq;
#pragma unroll
        for (int ai = 0; ai < 2; ++ai)
#pragma unroll
            for (int m = 0; m < 4; ++m) { const int r = row0 + ai * HALF + m * 16; const size_t off = (size_t)r * 1024 + col0; float ss = 0.f; const float s = rs[r] * (-1.44269504f);
#pragma unroll
                for (int bj = 0; bj < 2; ++bj)
#pragma unroll
                    for (int n = 0; n < 2; ++n) { const size_t o = off + bj * HALF + n * 16; f32x4 h = *(const f32x4*)(hio + o); const u32x2 pw = *(const u32x2*)(ple + o);
                        const f32x4 a = acc[ai][bj][m][n]; f32x4 g;
#pragma unroll
                        for (int j = 0; j < 4; ++j) g[j] = __builtin_amdgcn_rcpf(1.0f + __builtin_amdgcn_exp2f(a[j] * s));
                        h[0] += bf_lo(pw.x) * g[0]; h[1] += bf_hi(pw.x) * g[1]; h[2] += bf_lo(pw.y) * g[2]; h[3] += bf_hi(pw.y) * g[3];
                        *(f32x4*)(hio + o) = h; ss += (h[0] * h[0] + h[1] * h[1]) + (h[2] * h[2] + h[3] * h[3]); }
                ss += __shfl_xor(ss, 16); ss += __shfl_xor(ss, 32);
                if (fq == 0) part[(size_t)r * 16 + u.pn * 4 + wc] = ss; }
    }
};

template <class Epi, class Sched, bool ALIGN_EPI = false, bool SP2 = false>
__device__ __forceinline__ void gemm_phase(PG8_LAS unsigned char* lds, const Gemm g, const Sched& S, const Epi& E) {
    const int tid = threadIdx.x, wid = __builtin_amdgcn_readfirstlane(tid >> 6), lane = tid & 63, wr = wid >> 2, wc = wid & 3, fr = lane & 15, fq = lane >> 4;
    const int K = g.K, nt = K / BK;
    unsigned voffA[2], voffB[2];
#pragma unroll
    for (int i = 0; i < 2; ++i) { int R, C; stage_rc(tid * 16 + i * 8192, R, C); const int Rb = Epi::PERM ? ((R & ~31) + perm32(R & 31)) : R;
        voffA[i] = (unsigned)(R * K + C) * 2u; voffB[i] = (unsigned)(Rb * K + C) * 2u; }
    const size_t kstep = (size_t)(BK * 2);
    const size_t hstep = (size_t)HALF * K * 2;
    const size_t tstep = 2 * hstep;
    const unsigned ldsw = (unsigned)wid * 1024u;
    const int aoff = lds_byte(wr * 64 + fr, fq * 8), boff = lds_byte(wc * 32 + fr, fq * 8);
#define PG8_SA(b, h) (((b) * 2 + (h)) * HTB)
#define PG8_SB(b, h) ((4 + (b) * 2 + (h)) * HTB)
#define PG8_STAGE(bufoff, gbase, voff) do { _Pragma("unroll") for (int _i = 0; _i < 2; ++_i) \
        __builtin_amdgcn_global_load_lds((const unsigned*)((const char*)(gbase) + (voff)[_i]), (PG8_LAS unsigned*)(lds + (bufoff) + ldsw + _i * 8192), 16, 0, 0); } while (0)
#define PG8_LDA(dst, b, h) do { _Pragma("unroll") for (int m = 0; m < 4; ++m) _Pragma("unroll") for (int k = 0; k < 2; ++k) dst[m][k] = *(const PG8_LAS bf16x8*)(lds + PG8_SA(b, h) + aoff + m * 2048 + k * 1024); } while (0)
#define PG8_LDB(dst, b, h) do { _Pragma("unroll") for (int n = 0; n < 2; ++n) _Pragma("unroll") for (int k = 0; k < 2; ++k) dst[n][k] = *(const PG8_LAS bf16x8*)(lds + PG8_SB(b, h) + boff + n * 2048 + k * 1024); } while (0)
#define PG8_MMA(ai, bj, At, Bt) do { __builtin_amdgcn_s_setprio(1); _Pragma("unroll") for (int m = 0; m < 4; ++m) _Pragma("unroll") for (int n = 0; n < 2; ++n) _Pragma("unroll") for (int k = 0; k < 2; ++k) \
        acc[ai][bj][m][n] = __builtin_amdgcn_mfma_f32_16x16x32_bf16(Bt[n][k], At[m][k], acc[ai][bj][m][n], 0, 0, 0); __builtin_amdgcn_s_setprio(0); } while (0)
#define PG8_WAIT_V(n) asm volatile("s_waitcnt vmcnt(" #n ")" ::: "memory")
#define PG8_WAIT_L(n) asm volatile("s_waitcnt lgkmcnt(" #n ")" ::: "memory")
#define PG8_BAR __builtin_amdgcn_s_barrier()
#define PG8_SCHED __builtin_amdgcn_sched_barrier(0)
    Unit cur, nxt; int ui = 0;
    if (!S.next(0, cur)) return;
    f32x4 acc[2][2][4][2];
#pragma unroll
    for (int a = 0; a < 2; ++a)
#pragma unroll
        for (int b = 0; b < 2; ++b)
#pragma unroll
            for (int m = 0; m < 4; ++m)
#pragma unroll
                for (int n = 0; n < 2; ++n) acc[a][b][m][n] = (f32x4){0.f, 0.f, 0.f, 0.f};
    bf16x8 At[4][2], B0[2][2], B1[2][2];
    const char* cA = (const char*)g.A + (size_t)cur.pm * tstep; const char* cB = (const char*)g.Bt + (size_t)cur.pn * tstep;
    S.a_ready(cur);
    if constexpr (SP2) {
        PG8_STAGE(PG8_SB(0, 0), cB, voffB); PG8_STAGE(PG8_SB(0, 1), cB + hstep, voffB); PG8_STAGE(PG8_SA(0, 0), cA, voffA); PG8_STAGE(PG8_SA(0, 1), cA + hstep, voffA);
        if (wr == 1) PG8_BAR;
        PG8_WAIT_V(2); PG8_BAR;
        PG8_STAGE(PG8_SB(1, 0), cB + kstep, voffB); PG8_STAGE(PG8_SA(1, 0), cA + kstep, voffA); PG8_STAGE(PG8_SB(1, 1), cB + hstep + kstep, voffB);
        PG8_WAIT_V(6); PG8_BAR;
    } else {
        PG8_STAGE(PG8_SB(0, 0), cB, voffB); PG8_STAGE(PG8_SA(0, 0), cA, voffA); PG8_STAGE(PG8_SB(0, 1), cB + hstep, voffB); PG8_STAGE(PG8_SA(0, 1), cA + hstep, voffA);
        if (wr == 1) PG8_BAR;
        PG8_WAIT_V(4); PG8_BAR;
        PG8_STAGE(PG8_SB(1, 0), cB + kstep, voffB); PG8_STAGE(PG8_SA(1, 0), cA + kstep, voffA); PG8_STAGE(PG8_SB(1, 1), cB + hstep + kstep, voffB);
        PG8_WAIT_V(6); PG8_BAR;
    }
    for (;;) {
        const bool has_next = S.next(ui + 1, nxt);
        const char* nA = has_next ? (const char*)g.A + (size_t)nxt.pm * tstep : cA; const char* nB = has_next ? (const char*)g.Bt + (size_t)nxt.pn * tstep : cB;
        for (int t = 0; t < nt; t += 2) {
            const bool last = (t == nt - 2);
            const char* a1 = cA + (size_t)(t + 1) * kstep;
            const char* a2 = last ? nA : cA + (size_t)(t + 2) * kstep; const char* b2 = last ? nB : cB + (size_t)(t + 2) * kstep;
            const char* a3 = a2 + kstep; const char* b3 = b2 + kstep;
            if (last && has_next) S.a_ready(nxt);
            if constexpr (SP2) {
            PG8_LDB(B0, 0, 0); PG8_LDB(B1, 0, 1); PG8_SCHED; PG8_LDA(At, 0, 0); PG8_STAGE(PG8_SA(1, 1), a1 + hstep, voffA);
            PG8_WAIT_V(8); PG8_WAIT_L(0); PG8_BAR; PG8_MMA(0, 0, At, B0); PG8_MMA(0, 1, At, B1); PG8_BAR; PG8_SCHED;
            PG8_LDA(At, 0, 1); PG8_STAGE(PG8_SB(0, 0), b2, voffB); PG8_STAGE(PG8_SB(0, 1), b2 + hstep, voffB); PG8_STAGE(PG8_SA(0, 0), a2, voffA);
            PG8_WAIT_V(8); PG8_WAIT_L(0); PG8_BAR; PG8_MMA(1, 0, At, B0); PG8_MMA(1, 1, At, B1); PG8_BAR; PG8_SCHED;
            PG8_LDB(B0, 1, 0); PG8_LDB(B1, 1, 1); PG8_SCHED; PG8_LDA(At, 1, 0); PG8_STAGE(PG8_SA(0, 1), a2 + hstep, voffA);
            PG8_WAIT_V(8); PG8_WAIT_L(0); PG8_BAR; PG8_MMA(0, 0, At, B0); PG8_MMA(0, 1, At, B1); PG8_BAR; PG8_SCHED;
            PG8_LDA(At, 1, 1); PG8_STAGE(PG8_SB(1, 0), b3, voffB); PG8_STAGE(PG8_SB(1, 1), b3 + hstep, voffB); PG8_STAGE(PG8_SA(1, 0), a3, voffA);
            PG8_WAIT_V(8); PG8_WAIT_L(0); PG8_BAR; PG8_MMA(1, 0, At, B0); PG8_MMA(1, 1, At, B1); PG8_BAR; PG8_SCHED;
            } else {
            PG8_LDB(B0, 0, 0); PG8_SCHED; PG8_LDA(At, 0, 0); PG8_STAGE(PG8_SA(1, 1), a1 + hstep, voffA);
            PG8_WAIT_L(8); PG8_BAR; PG8_WAIT_L(0); PG8_MMA(0, 0, At, B0); PG8_BAR; PG8_SCHED;
            PG8_LDB(B1, 0, 1); PG8_STAGE(PG8_SB(0, 0), b2, voffB);
            PG8_BAR; PG8_WAIT_L(0); PG8_MMA(0, 1, At, B1); PG8_BAR;
            PG8_LDA(At, 0, 1); PG8_STAGE(PG8_SA(0, 0), a2, voffA);
            PG8_BAR; PG8_WAIT_L(0); PG8_MMA(1, 0, At, B0); PG8_BAR; PG8_SCHED;
            PG8_STAGE(PG8_SB(0, 1), b2 + hstep, voffB);
            PG8_WAIT_V(6); PG8_BAR; PG8_MMA(1, 1, At, B1); PG8_BAR;
            PG8_LDB(B0, 1, 0); PG8_SCHED; PG8_LDA(At, 1, 0); PG8_STAGE(PG8_SA(0, 1), a2 + hstep, voffA);
            PG8_WAIT_L(8); PG8_BAR; PG8_WAIT_L(0); PG8_MMA(0, 0, At, B0); PG8_BAR; PG8_SCHED;
            PG8_LDB(B1, 1, 1); PG8_STAGE(PG8_SB(1, 0), b3, voffB);
            PG8_BAR; PG8_WAIT_L(0); PG8_MMA(0, 1, At, B1); PG8_BAR;
            PG8_LDA(At, 1, 1); PG8_STAGE(PG8_SA(1, 0), a3, voffA);
            PG8_BAR; PG8_WAIT_L(0); PG8_MMA(1, 0, At, B0); PG8_BAR; PG8_SCHED;
            PG8_STAGE(PG8_SB(1, 1), b3 + hstep, voffB);
            PG8_WAIT_V(6); PG8_BAR; PG8_MMA(1, 1, At, B1); PG8_BAR;
            }
        }
        if constexpr (ALIGN_EPI) { if (wr == 0) PG8_BAR; }
        if constexpr (!Epi::AFTER_DRAIN) { E(acc, cur, wr, wc, fr, fq); S.done(cur); }
        if (!has_next) break;
#pragma unroll
        for (int a = 0; a < 2; ++a)
#pragma unroll
            for (int b = 0; b < 2; ++b)
#pragma unroll
                for (int m = 0; m < 4; ++m)
#pragma unroll
                    for (int n = 0; n < 2; ++n) acc[a][b][m][n] = (f32x4){0.f, 0.f, 0.f, 0.f};
        cur = nxt; cA = nA; cB = nB; ++ui;
        if constexpr (ALIGN_EPI) { if (wr == 1) PG8_BAR; }
    }
    PG8_WAIT_V(0);
    if constexpr (!ALIGN_EPI) { if (wr == 0) PG8_BAR; }
    PG8_BAR;
    if constexpr (Epi::AFTER_DRAIN) { E.fused(acc, cur, wr, wc, fr, fq, lds, wid, lane); S.done(cur); }
#undef PG8_SA
#undef PG8_SB
#undef PG8_STAGE
#undef PG8_LDA
#undef PG8_LDB
#undef PG8_MMA
#undef PG8_WAIT_V
#undef PG8_WAIT_L
#undef PG8_BAR
#undef PG8_SCHED
}
}

constexpr int NWAVES = 8;
#ifndef MK_N_LAUNCHES
#define MK_N_LAUNCHES 1
#endif
constexpr int NPHASE = 9;
constexpr int N_LAUNCHES = MK_N_LAUNCHES;

constexpr int T = 16384, D = 1024, SEQ = 4096;
constexpr float EPS = 1e-6f;
constexpr size_t MiB = 1u << 20;
constexpr size_t WS_CTL = 0, CTL_ZERO_BYTES = 16384 + 65536;
constexpr size_t WS_RCNT = 16384;
constexpr size_t WS_WIN = 1 * MiB, WS_WOUT = 6 * MiB, WS_WQ = 8 * MiB, WS_WGATE = 12 * MiB, WS_WPLE = 14 * MiB;
constexpr size_t WS_RS1 = 14 * MiB + 512 * 1024, WS_RS3 = WS_RS1 + 65536, WS_PART4 = 15 * MiB, WS_PART2 = 16 * MiB;
constexpr size_t WS_A = 17 * MiB;
constexpr size_t WS_PB = 49 * MiB;
constexpr size_t WS_PLE = 57 * MiB;
constexpr size_t WS_TAB = 89 * MiB;
constexpr size_t WS_SEL = 153 * MiB;
constexpr size_t WS_M = 169 * MiB;
constexpr size_t WS_F = 201 * MiB;
constexpr size_t WS_KEYSB = 240 * MiB;
constexpr size_t WS_WSB = 241 * MiB;
constexpr size_t WS_END = 256 * MiB;
constexpr int RING_BYTES = 131072, MISC_OFF = RING_BYTES + 320, LDS_BYTES = 147456;

#define GAS __attribute__((address_space(1)))
#define LAS __attribute__((address_space(3)))
typedef unsigned short bf16;
typedef unsigned v4u __attribute__((ext_vector_type(4)));
typedef unsigned v2u __attribute__((ext_vector_type(2)));
typedef float f32x4 __attribute__((ext_vector_type(4)));
#define LDS_WAIT() asm volatile("s_waitcnt lgkmcnt(0)" ::: "memory")
__device__ __forceinline__ unsigned f2bf(float f) { unsigned u = __builtin_bit_cast(unsigned, f); return (u + 0x7fffu + ((u >> 16) & 1u)) >> 16; }
__device__ __forceinline__ unsigned pk2(float lo, float hi) { return f2bf(lo) | (f2bf(hi) << 16); }
__device__ __forceinline__ float blo(unsigned w) { return __uint_as_float(w << 16); }
__device__ __forceinline__ float bhi(unsigned w) { return __uint_as_float(w & 0xffff0000u); }
__device__ __forceinline__ float wave_sum(float v) {
#pragma unroll
    for (int o = 1; o < 64; o <<= 1) v += __shfl_xor(v, o);
    return v;
}
__device__ __forceinline__ float dot4(f32x4 a, f32x4 b) { return (a[0] * b[0] + a[1] * b[1]) + (a[2] * b[2] + a[3] * b[3]); }

#define XB_TMO      128
#define XB_XCNT(j)  (256  + 64 * (j))
#define XB_XSUB(j)  (1280 + 64 * (j))
#define XB_XGEN(j)  (2304 + 64 * (j))
#define XB_TOP      3328
#define XB_TOPGEN   3392
#define XCD_BAR_WORDS 3456
#define XB_SPIN_CAP (1u << 18)

__device__ __forceinline__ unsigned xb_ld(unsigned* p)              { return __hip_atomic_load(p, __ATOMIC_RELAXED, __HIP_MEMORY_SCOPE_AGENT); }
__device__ __forceinline__ unsigned xb_add(unsigned* p, unsigned v) { return __hip_atomic_fetch_add(p, v, __ATOMIC_RELAXED, __HIP_MEMORY_SCOPE_AGENT); }
__device__ __forceinline__ unsigned xb_xcc_id() { return (unsigned)__builtin_amdgcn_s_getreg((3 << 11) | 20) & 0xFu; }
#define XB_SPIN(cond, bar) do { unsigned _sp = 0; while (cond) { __builtin_amdgcn_s_sleep(1); \
    if ((++_sp & 255u) == 0u) { if (xb_ld(&(bar)[XB_TMO])) break; if (_sp > XB_SPIN_CAP) { atomicAdd(&(bar)[XB_TMO], 1u); break; } } } } while (0)

struct XcdBarrier {
    unsigned* bar; unsigned x;
    volatile LAS unsigned* st;
};

__device__ __forceinline__ XcdBarrier xcd_barrier_post(unsigned* bar, volatile LAS unsigned* st) {
    XcdBarrier b; b.bar = bar; b.x = xb_xcc_id(); b.st = st;
    if (threadIdx.x == 0) (void)xb_add(&bar[XB_XCNT(b.x)], 1u);
    return b;
}
__device__ __forceinline__ void xcd_barrier_complete(unsigned* bar, unsigned x, unsigned& nloc, unsigned& nx) {
    const unsigned G = gridDim.x * gridDim.y * gridDim.z;
    unsigned sum, cnt, mine, sp = 0u;
    for (;;) {
        sum = 0u; cnt = 0u; mine = 0u;
#pragma unroll
        for (unsigned j = 0; j < 16; ++j) { const unsigned c = xb_ld(&bar[XB_XCNT(j)]); sum += c; cnt += (c > 0u) ? 1u : 0u; mine = (j == x) ? c : mine; }
        if (sum == G) break;
        __builtin_amdgcn_s_sleep(1);
        if ((++sp & 255u) == 0u) { if (xb_ld(&bar[XB_TMO])) break; if (sp > XB_SPIN_CAP) { atomicAdd(&bar[XB_TMO], 1u); break; } }
    }
    nloc = mine > 0u ? mine : 1u; nx = cnt > 0u ? cnt : 1u;
}

__device__ __forceinline__ void xcd_barrier(const XcdBarrier& b) {
    asm volatile("s_waitcnt vmcnt(0)" ::: "memory");
    __syncthreads();
    if (threadIdx.x == 0) {
        unsigned* bar = b.bar;
        __builtin_amdgcn_s_waitcnt(0);
        unsigned nloc = b.st[0], nx = b.st[1];
        if (nloc == 0u) { xcd_barrier_complete(bar, b.x, nloc, nx); b.st[0] = nloc; b.st[1] = nx; }
        const unsigned old = xb_add(&bar[XB_XSUB(b.x)], 1u);
        const unsigned gen = old / nloc;
        if (old + 1u == (gen + 1u) * nloc) {
            __builtin_amdgcn_fence(__ATOMIC_RELEASE, "agent");
            asm volatile("s_waitcnt vmcnt(0)" ::: "memory");
            const unsigned og = xb_add(&bar[XB_TOP], 1u);
            const unsigned tg = og / nx;
            if (og + 1u == (tg + 1u) * nx) xb_add(&bar[XB_TOPGEN], 1u);
            else XB_SPIN(xb_ld(&bar[XB_TOPGEN]) == tg, bar);
            __builtin_amdgcn_fence(__ATOMIC_ACQUIRE, "agent");
            xb_add(&bar[XB_XGEN(b.x)], 1u);
            asm volatile("s_waitcnt vmcnt(0)" ::: "memory");
        } else {
            XB_SPIN(xb_ld(&bar[XB_XGEN(b.x)]) == gen, bar);
            __builtin_amdgcn_fence(__ATOMIC_ACQUIRE, "agent");
            asm volatile("s_waitcnt vmcnt(0)" ::: "memory");
        }
    }
    __syncthreads();
}

__device__ __forceinline__ void p0_transpose_item(const float* W, const float* gain, int K, int N, bf16* WT, LAS float* scr, int item, int lane) {
    const int nblk = N / 32, kb = item / nblk, nb = item % nblk, k0 = 64 * kb, n0 = 32 * nb;
#pragma unroll 8
    for (int i = 0; i < 32; ++i) { const int kk = 2 * i + (lane >> 5); const float g = gain ? gain[k0 + kk] : 1.0f; scr[kk * 33 + (lane & 31)] = W[(size_t)(k0 + kk) * N + n0 + (lane & 31)] * g; }
    LDS_WAIT(); asm volatile("" ::: "memory");
    const int c = lane & 7;
#pragma unroll
    for (int j = 0; j < 4; ++j) { const int n = (lane >> 3) + 8 * j; const LAS float* s = scr + (8 * c) * 33 + n;
        v4u o; o.x = pk2(s[0 * 33], s[1 * 33]); o.y = pk2(s[2 * 33], s[3 * 33]); o.z = pk2(s[4 * 33], s[5 * 33]); o.w = pk2(s[6 * 33], s[7 * 33]);
        *(v4u*)(WT + (size_t)(n0 + n) * K + k0 + 8 * c) = o; }
    LDS_WAIT(); asm volatile("" ::: "memory");
}

__device__ __forceinline__ int t5_bucket(int rel) {
    const int n = rel < 0 ? -rel : rel;
    const int large = 8 + (n >= 12) + (n >= 16) + (n >= 23) + (n >= 32) + (n >= 46) + (n >= 64) + (n >= 91);
    return (rel > 0 ? 16 : 0) + (n < 8 ? n : large);
}

__device__ __forceinline__ void gmlp_unit(LAS unsigned char* lds, int nb, int g, const bf16* zA, const float* ln_g, const float* ln_b, const float* w_s, const float* b_s, const float* beta, bf16* mix, int tid) {
    constexpr int VP = 132;
    LAS float* vln = (LAS float*)lds;
    const int i = tid >> 2, cq = tid & 3, t = nb * 128 + i, cb = g * 128 + cq * 32;
    float x[32];
    { const v4u* vp = (const v4u*)(zA + (size_t)t * 1024 + 512 + cb);
#pragma unroll
      for (int k = 0; k < 4; ++k) { const v4u w = vp[k]; x[8 * k + 0] = blo(w.x); x[8 * k + 1] = bhi(w.x); x[8 * k + 2] = blo(w.y); x[8 * k + 3] = bhi(w.y); x[8 * k + 4] = blo(w.z); x[8 * k + 5] = bhi(w.z); x[8 * k + 6] = blo(w.w); x[8 * k + 7] = bhi(w.w); } }
    float s = 0.f;
#pragma unroll
    for (int c = 0; c < 32; ++c) s += x[c];
    s += __shfl_xor(s, 1); s += __shfl_xor(s, 2);
    const float mean = s * (1.0f / 128.0f); float q = 0.f;
#pragma unroll
    for (int c = 0; c < 32; ++c) { x[c] -= mean; q += x[c] * x[c]; }
    q += __shfl_xor(q, 1); q += __shfl_xor(q, 2);
    const float rstd = 1.0f / sqrtf(q * (1.0f / 128.0f) + EPS);
#pragma unroll
    for (int k = 0; k < 8; ++k) { const f32x4 gg = *(const f32x4*)(ln_g + cb + 4 * k), bb = *(const f32x4*)(ln_b + cb + 4 * k); f32x4 y;
#pragma unroll
        for (int e = 0; e < 4; ++e) y[e] = x[4 * k + e] * rstd * gg[e] + bb[e];
        *(LAS f32x4*)(vln + i * VP + cq * 32 + 4 * k) = y; }
    __syncthreads();
    float acc[32];
#pragma unroll
    for (int c = 0; c < 32; ++c) acc[c] = 0.f;
    const int jmax = (i < 64) ? 64 : 128;
    const float* wrow = w_s + ((size_t)g * 128 + i) * 128;
    for (int j0 = 0; j0 < jmax; j0 += 4) { const f32x4 wv = *(const f32x4*)(wrow + j0);
#pragma unroll
        for (int jj = 0; jj < 4; ++jj)
#pragma unroll
            for (int k = 0; k < 8; ++k) { const f32x4 vv = *(const LAS f32x4*)(vln + (j0 + jj) * VP + cq * 32 + 4 * k);
#pragma unroll
                for (int e = 0; e < 4; ++e) acc[4 * k + e] += wv[jj] * vv[e]; } }
    const float bias = b_s[g * 128 + i];
    float ss = 0.f;
    { const v4u* up = (const v4u*)(zA + (size_t)t * 1024 + cb);
#pragma unroll
      for (int k = 0; k < 4; ++k) { const v4u w = up[k]; float u8[8] = {blo(w.x), bhi(w.x), blo(w.y), bhi(w.y), blo(w.z), bhi(w.z), blo(w.w), bhi(w.w)};
#pragma unroll
          for (int e = 0; e < 8; ++e) { const float o = u8[e] * (acc[8 * k + e] + bias); acc[8 * k + e] = o; ss += o * o; } } }
    ss += __shfl_xor(ss, 1); ss += __shfl_xor(ss, 2);
    const float rr = 1.0f / sqrtf(ss * (1.0f / 128.0f) + EPS);
    { v4u* op = (v4u*)(mix + (size_t)t * 1024 + cb);
#pragma unroll
      for (int k = 0; k < 4; ++k) { const f32x4 b0 = *(const f32x4*)(beta + cb + 8 * k), b1 = *(const f32x4*)(beta + cb + 8 * k + 4); v4u w;
          w.x = pk2(acc[8 * k + 0] * rr * b0[0], acc[8 * k + 1] * rr * b0[1]); w.y = pk2(acc[8 * k + 2] * rr * b0[2], acc[8 * k + 3] * rr * b0[3]);
          w.z = pk2(acc[8 * k + 4] * rr * b1[0], acc[8 * k + 5] * rr * b1[1]); w.w = pk2(acc[8 * k + 6] * rr * b1[2], acc[8 * k + 7] * rr * b1[3]); op[k] = w; } }
    __syncthreads();
}

typedef short bf16x8_t __attribute__((ext_vector_type(8)));
typedef short s16x4_t __attribute__((ext_vector_type(4)));
typedef float f32x16 __attribute__((ext_vector_type(16)));
typedef __bf16 bf2_t __attribute__((ext_vector_type(2)));
typedef float f2_t __attribute__((ext_vector_type(2)));
__device__ __forceinline__ unsigned cvt2bf(float a, float b) { const f2_t v = {a, b}; const bf2_t r = __builtin_convertvector(v, bf2_t); return __builtin_bit_cast(unsigned, r); }
template <int OFF> __device__ __forceinline__ s16x4_t tr_read(unsigned addr) { s16x4_t r; asm volatile("ds_read_b64_tr_b16 %0, %1 offset:%2" : "=&v"(r) : "v"(addr), "i"(OFF) : "memory"); return r; }
constexpr int AT_KP = 272, AT_VP = 320, AT_KBUF = 64 * AT_KP, AT_VBUF = 64 * AT_VP, AT_OFF_V = 2 * AT_KBUF, AT_OFF_BT = AT_OFF_V + 2 * AT_VBUF;
static_assert(AT_OFF_BT + 1024 <= RING_BYTES, "attention LDS map");
template <int DB> __device__ __forceinline__ void attn_pv(f32x16& o, unsigned va, const bf16x8_t (&pf)[2][2]) {
    const s16x4_t l00 = tr_read<0 * 32 * AT_VP + 0 * 16 * AT_VP + DB * 64>(va), h00 = tr_read<0 * 32 * AT_VP + 0 * 16 * AT_VP + 8 * AT_VP + DB * 64>(va);
    const s16x4_t l01 = tr_read<0 * 32 * AT_VP + 1 * 16 * AT_VP + DB * 64>(va), h01 = tr_read<0 * 32 * AT_VP + 1 * 16 * AT_VP + 8 * AT_VP + DB * 64>(va);
    const s16x4_t l10 = tr_read<1 * 32 * AT_VP + 0 * 16 * AT_VP + DB * 64>(va), h10 = tr_read<1 * 32 * AT_VP + 0 * 16 * AT_VP + 8 * AT_VP + DB * 64>(va);
    const s16x4_t l11 = tr_read<1 * 32 * AT_VP + 1 * 16 * AT_VP + DB * 64>(va), h11 = tr_read<1 * 32 * AT_VP + 1 * 16 * AT_VP + 8 * AT_VP + DB * 64>(va);
    asm volatile("s_waitcnt lgkmcnt(0)" ::: "memory"); __builtin_amdgcn_sched_barrier(0);
#define AT_PK(L, H) (bf16x8_t){L[0], L[1], L[2], L[3], H[0], H[1], H[2], H[3]}
    o = __builtin_amdgcn_mfma_f32_32x32x16_bf16(AT_PK(l00, h00), pf[0][0], o, 0, 0, 0);
    o = __builtin_amdgcn_mfma_f32_32x32x16_bf16(AT_PK(l01, h01), pf[0][1], o, 0, 0, 0);
    o = __builtin_amdgcn_mfma_f32_32x32x16_bf16(AT_PK(l10, h10), pf[1][0], o, 0, 0, 0);
    o = __builtin_amdgcn_mfma_f32_32x32x16_bf16(AT_PK(l11, h11), pf[1][1], o, 0, 0, 0);
#undef AT_PK
}
__device__ __forceinline__ void attn_unit(LAS unsigned char* lds, int b, int h, int jb, const bf16* qb, const bf16* kb, const bf16* vb, const float* rel_bias, float lam, const float* subln_g, bf16* mix, int tid, int lane, int wave) {
    const int comp = wave >> 2, qsub = wave & 3, r = lane & 31, hh = lane >> 5;
    const int cq = 2 * jb + (qsub >> 1), nt = 2 * jb + 2;
    const int qpos = 128 * jb + 32 * qsub + r;
    const size_t tq = (size_t)b * SEQ + qpos;
    LAS float* bt = (LAS float*)(lds + AT_OFF_BT);
    __syncthreads();
    if (tid < 256) bt[tid] = (rel_bias[t5_bucket(tid - 192) * 4 + h] - rel_bias[15 * 4 + h]) * 1.44269504f;
    bf16x8_t qf[4];
#pragma unroll
    for (int ks = 0; ks < 4; ++ks) qf[ks] = *(const bf16x8_t*)(qb + tq * 512 + h * 128 + comp * 64 + 16 * ks + 8 * hh);
    f32x16 oacc[4];
#pragma unroll
    for (int db = 0; db < 4; ++db)
#pragma unroll
        for (int i = 0; i < 16; ++i) oacc[db][i] = 0.f;
    float m = 0.f, l = 0.f;
    const int srow = tid >> 4, sc16 = tid & 15;
    const size_t gsrc = ((size_t)b * SEQ + srow) * 512 + h * 128 + sc16 * 8;
    v4u kreg[2], vreg[2];
#define AT_LOAD(t) do { _Pragma("unroll") for (int c_ = 0; c_ < 2; ++c_) { const size_t o_ = gsrc + ((size_t)(t) * 64 + 32 * c_) * 512; kreg[c_] = *(const v4u*)(kb + o_); vreg[c_] = *(const v4u*)(vb + o_); } } while (0)
#define AT_WRITE(buf) do { _Pragma("unroll") for (int c_ = 0; c_ < 2; ++c_) { *(LAS v4u*)(lds + (buf) * AT_KBUF + (srow + 32 * c_) * AT_KP + sc16 * 16) = kreg[c_]; \
        *(LAS v4u*)(lds + AT_OFF_V + (buf) * AT_VBUF + (srow + 32 * c_) * AT_VP + sc16 * 16) = vreg[c_]; } } while (0)
    AT_LOAD(0); AT_WRITE(0);
    __syncthreads();
    const int i16 = lane & 15, q4 = i16 >> 2, p4 = i16 & 3, blk = (lane >> 4) & 1;
    const unsigned vrd = (unsigned)(size_t)(lds + AT_OFF_V) + (unsigned)((4 * hh + q4) * AT_VP + 32 * blk + 8 * p4);
    for (int t = 0; t < nt; ++t) {
        const int cur = t & 1;
        if (t + 1 < nt) AT_LOAD(t + 1);
        if (t <= cq) {
            const LAS unsigned char* Kb = lds + cur * AT_KBUF + r * AT_KP + comp * 128 + 16 * hh;
            f32x16 s0, s1;
#pragma unroll
            for (int i = 0; i < 16; ++i) { s0[i] = -m; s1[i] = -m; }
#pragma unroll
            for (int ks = 0; ks < 4; ++ks) { const bf16x8_t a0 = *(const LAS bf16x8_t*)(Kb + 32 * ks), a1 = *(const LAS bf16x8_t*)(Kb + 32 * AT_KP + 32 * ks);
                s0 = __builtin_amdgcn_mfma_f32_32x32x16_bf16(a0, qf[ks], s0, 0, 0, 0); s1 = __builtin_amdgcn_mfma_f32_32x32x16_bf16(a1, qf[ks], s1, 0, 0, 0); }
            if (cq - t <= 2) {
                const LAS float* bp = bt + (t * 64 - qpos + 192 + 4 * hh);
#pragma unroll
                for (int i = 0; i < 16; ++i) { s0[i] += bp[(i & 3) + 8 * (i >> 2)]; s1[i] += bp[32 + (i & 3) + 8 * (i >> 2)]; }
            }
            float mt = fmaxf(s0[0], s1[0]);
#pragma unroll
            for (int i = 1; i < 16; ++i) mt = fmaxf(mt, fmaxf(s0[i], s1[i]));
            { auto rr = __builtin_amdgcn_permlane32_swap(__float_as_uint(mt), __float_as_uint(mt), false, false); mt = fmaxf(__uint_as_float(rr[0]), __uint_as_float(rr[1])); }
            if (t == 0 || !__all(mt <= 6.0f)) {
                const float dm = (t == 0) ? mt : fmaxf(mt, 0.f), alpha = (t == 0) ? 1.0f : __builtin_amdgcn_exp2f(-dm); m += dm; l *= alpha;
#pragma unroll
                for (int i = 0; i < 16; ++i) { s0[i] -= dm; s1[i] -= dm; }
#pragma unroll
                for (int db = 0; db < 4; ++db)
#pragma unroll
                    for (int i = 0; i < 16; ++i) oacc[db][i] *= alpha;
            }
            float ps = 0.f;
#pragma unroll
            for (int i = 0; i < 16; ++i) { s0[i] = __builtin_amdgcn_exp2f(s0[i]); s1[i] = __builtin_amdgcn_exp2f(s1[i]); ps += s0[i] + s1[i]; }
            l += ps;
            bf16x8_t pf[2][2];
#pragma unroll
            for (int sx = 0; sx < 2; ++sx) {
                v4u w0, w1;
                w0.x = cvt2bf(s0[8 * sx + 0], s0[8 * sx + 1]); w0.y = cvt2bf(s0[8 * sx + 2], s0[8 * sx + 3]); w0.z = cvt2bf(s0[8 * sx + 4], s0[8 * sx + 5]); w0.w = cvt2bf(s0[8 * sx + 6], s0[8 * sx + 7]);
                w1.x = cvt2bf(s1[8 * sx + 0], s1[8 * sx + 1]); w1.y = cvt2bf(s1[8 * sx + 2], s1[8 * sx + 3]); w1.z = cvt2bf(s1[8 * sx + 4], s1[8 * sx + 5]); w1.w = cvt2bf(s1[8 * sx + 6], s1[8 * sx + 7]);
                pf[0][sx] = __builtin_bit_cast(bf16x8_t, w0); pf[1][sx] = __builtin_bit_cast(bf16x8_t, w1);
            }
            const unsigned va = vrd + (unsigned)(cur * AT_VBUF);
            attn_pv<0>(oacc[0], va, pf); attn_pv<1>(oacc[1], va, pf); attn_pv<2>(oacc[2], va, pf); attn_pv<3>(oacc[3], va, pf);
        }
        if (t + 1 < nt) AT_WRITE(cur ^ 1);
        __syncthreads();
    }
#undef AT_LOAD
#undef AT_WRITE
    l += __shfl_xor(l, 32);
    const float inv = 1.0f / l;
    LAS float* xch = (LAS float*)lds + (size_t)qsub * 64 * 64 + lane;
    if (comp == 1) {
        const float sc = inv * lam;
#pragma unroll
        for (int db = 0; db < 4; ++db)
#pragma unroll
            for (int i = 0; i < 16; ++i) xch[(db * 16 + i) * 64] = oacc[db][i] * sc;
    }
    __syncthreads();
    if (comp == 0) {
        float ss = 0.f;
#pragma unroll
        for (int db = 0; db < 4; ++db)
#pragma unroll
            for (int i = 0; i < 16; ++i) { const float rv = oacc[db][i] * inv - xch[(db * 16 + i) * 64]; oacc[db][i] = rv; ss += rv * rv; }
        ss += __shfl_xor(ss, 32);
        const float rr = 0.8f / sqrtf(ss * (1.0f / 128.0f) + EPS);
        bf16* orow = mix + tq * 1024 + 512 + h * 128 + 4 * hh;
#pragma unroll
        for (int db = 0; db < 4; ++db)
#pragma unroll
            for (int g4 = 0; g4 < 4; ++g4) { const int dv0 = 32 * db + 8 * g4; const f32x4 gg = *(const f32x4*)(subln_g + dv0 + 4 * hh);
                v2u w; w.x = cvt2bf(oacc[db][4 * g4 + 0] * rr * gg[0], oacc[db][4 * g4 + 1] * rr * gg[1]); w.y = cvt2bf(oacc[db][4 * g4 + 2] * rr * gg[2], oacc[db][4 * g4 + 3] * rr * gg[3]);
                *(v2u*)(orow + dv0) = w; }
    }
}

constexpr int GM_VP = 320, GM_TILE = 128 * GM_VP;
template <int CB> __device__ __forceinline__ void gmlp_cb(f32x16& acc, unsigned va, const bf16x8_t (&wf)[8], bool full) {
#define GM_RD(ks) const s16x4_t l##ks = tr_read<ks * 16 * GM_VP + CB * 64>(va), h##ks = tr_read<ks * 16 * GM_VP + 4 * GM_VP + CB * 64>(va)
#define GM_PK(L, H) (bf16x8_t){L[0], L[1], L[2], L[3], H[0], H[1], H[2], H[3]}
    { GM_RD(0); GM_RD(1); GM_RD(2); GM_RD(3);
      asm volatile("s_waitcnt lgkmcnt(0)" ::: "memory"); __builtin_amdgcn_sched_barrier(0);
      acc = __builtin_amdgcn_mfma_f32_32x32x16_bf16(GM_PK(l0, h0), wf[0], acc, 0, 0, 0); acc = __builtin_amdgcn_mfma_f32_32x32x16_bf16(GM_PK(l1, h1), wf[1], acc, 0, 0, 0);
      acc = __builtin_amdgcn_mfma_f32_32x32x16_bf16(GM_PK(l2, h2), wf[2], acc, 0, 0, 0); acc = __builtin_amdgcn_mfma_f32_32x32x16_bf16(GM_PK(l3, h3), wf[3], acc, 0, 0, 0); }
    if (full) { GM_RD(4); GM_RD(5); GM_RD(6); GM_RD(7);
      asm volatile("s_waitcnt lgkmcnt(0)" ::: "memory"); __builtin_amdgcn_sched_barrier(0);
      acc = __builtin_amdgcn_mfma_f32_32x32x16_bf16(GM_PK(l4, h4), wf[4], acc, 0, 0, 0); acc = __builtin_amdgcn_mfma_f32_32x32x16_bf16(GM_PK(l5, h5), wf[5], acc, 0, 0, 0);
      acc = __builtin_amdgcn_mfma_f32_32x32x16_bf16(GM_PK(l6, h6), wf[6], acc, 0, 0, 0); acc = __builtin_amdgcn_mfma_f32_32x32x16_bf16(GM_PK(l7, h7), wf[7], acc, 0, 0, 0); }
#undef GM_RD
#undef GM_PK
}
__device__ __forceinline__ void gmlp_pair(LAS unsigned char* lds, int upair, const bf16* zA, const float* ln_g, const float* ln_b, const bf16* wsb, const float* b_s, const float* beta, bf16* mix, int lane, int wave) {
    const int unit = 2 * upair + (wave >> 2), nb = unit >> 2, g = unit & 3, ib = wave & 3, r = lane & 31, hh = lane >> 5;
    const int t = nb * 128 + ib * 32 + r;
    LAS unsigned char* img = lds + (wave >> 2) * GM_TILE;
    __syncthreads();
    {
        float x[64];
        const v4u* vp = (const v4u*)(zA + (size_t)t * 1024 + 512 + g * 128 + 64 * hh);
#pragma unroll
        for (int k = 0; k < 8; ++k) { const v4u w = vp[k]; x[8 * k + 0] = blo(w.x); x[8 * k + 1] = bhi(w.x); x[8 * k + 2] = blo(w.y); x[8 * k + 3] = bhi(w.y); x[8 * k + 4] = blo(w.z); x[8 * k + 5] = bhi(w.z); x[8 * k + 6] = blo(w.w); x[8 * k + 7] = bhi(w.w); }
        float sm = 0.f;
#pragma unroll
        for (int c = 0; c < 64; ++c) sm += x[c];
        sm += __shfl_xor(sm, 32);
        const float mean = sm * (1.0f / 128.0f); float q = 0.f;
#pragma unroll
        for (int c = 0; c < 64; ++c) { x[c] -= mean; q += x[c] * x[c]; }
        q += __shfl_xor(q, 32);
        const float rstd = 1.0f / sqrtf(q * (1.0f / 128.0f) + EPS);
        const float* gp = ln_g + g * 128 + 64 * hh; const float* bp = ln_b + g * 128 + 64 * hh;
#pragma unroll
        for (int k = 0; k < 8; ++k) { const f32x4 g0 = *(const f32x4*)(gp + 8 * k), g1 = *(const f32x4*)(gp + 8 * k + 4), b0 = *(const f32x4*)(bp + 8 * k), b1 = *(const f32x4*)(bp + 8 * k + 4); v4u w;
            w.x = cvt2bf(x[8 * k + 0] * rstd * g0[0] + b0[0], x[8 * k + 1] * rstd * g0[1] + b0[1]); w.y = cvt2bf(x[8 * k + 2] * rstd * g0[2] + b0[2], x[8 * k + 3] * rstd * g0[3] + b0[3]);
            w.z = cvt2bf(x[8 * k + 4] * rstd * g1[0] + b1[0], x[8 * k + 5] * rstd * g1[1] + b1[1]); w.w = cvt2bf(x[8 * k + 6] * rstd * g1[2] + b1[2], x[8 * k + 7] * rstd * g1[3] + b1[3]);
            *(LAS v4u*)(img + (ib * 32 + r) * GM_VP + 128 * hh + 16 * k) = w; }
    }
    bf16x8_t wf[8];
#pragma unroll
    for (int ks = 0; ks < 8; ++ks) wf[ks] = *(const bf16x8_t*)(wsb + ((size_t)g * 128 + ib * 32 + r) * 128 + 16 * ks + 8 * hh);
    __syncthreads();
    f32x16 sacc[4];
#pragma unroll
    for (int cb = 0; cb < 4; ++cb)
#pragma unroll
        for (int i = 0; i < 16; ++i) sacc[cb][i] = 0.f;
    const int i16 = lane & 15, q4 = i16 >> 2, p4 = i16 & 3, blk = (lane >> 4) & 1;
    const unsigned va = (unsigned)(size_t)img + (unsigned)((8 * hh + q4) * GM_VP + 32 * blk + 8 * p4);
    const bool full = ib >= 2;
    gmlp_cb<0>(sacc[0], va, wf, full); gmlp_cb<1>(sacc[1], va, wf, full); gmlp_cb<2>(sacc[2], va, wf, full); gmlp_cb<3>(sacc[3], va, wf, full);
    const float bias = b_s[g * 128 + ib * 32 + r];
    const bf16* urow = zA + (size_t)t * 1024 + g * 128 + 4 * hh;
    float ss = 0.f;
#pragma unroll
    for (int cb = 0; cb < 4; ++cb)
#pragma unroll
        for (int g4 = 0; g4 < 4; ++g4) { const v2u uw = *(const v2u*)(urow + 32 * cb + 8 * g4);
            const float o0 = blo(uw.x) * (sacc[cb][4 * g4 + 0] + bias), o1 = bhi(uw.x) * (sacc[cb][4 * g4 + 1] + bias), o2 = blo(uw.y) * (sacc[cb][4 * g4 + 2] + bias), o3 = bhi(uw.y) * (sacc[cb][4 * g4 + 3] + bias);
            sacc[cb][4 * g4 + 0] = o0; sacc[cb][4 * g4 + 1] = o1; sacc[cb][4 * g4 + 2] = o2; sacc[cb][4 * g4 + 3] = o3; ss += (o0 * o0 + o1 * o1) + (o2 * o2 + o3 * o3); }
    ss += __shfl_xor(ss, 32);
    const float rr = 1.0f / sqrtf(ss * (1.0f / 128.0f) + EPS);
    bf16* orow = mix + (size_t)t * 1024 + g * 128 + 4 * hh; const float* btp = beta + g * 128 + 4 * hh;
#pragma unroll
    for (int cb = 0; cb < 4; ++cb)
#pragma unroll
        for (int g4 = 0; g4 < 4; ++g4) { const f32x4 bb = *(const f32x4*)(btp + 32 * cb + 8 * g4); v2u w;
            w.x = cvt2bf(sacc[cb][4 * g4 + 0] * rr * bb[0], sacc[cb][4 * g4 + 1] * rr * bb[1]); w.y = cvt2bf(sacc[cb][4 * g4 + 2] * rr * bb[2], sacc[cb][4 * g4 + 3] * rr * bb[3]);
            *(v2u*)(orow + 32 * cb + 8 * g4) = w; }
}

#ifndef SEL_HD
#define SEL_HD __device__ __forceinline__
#endif
#define SEL_CE_D(a, b) do { const float hi_ = fmaxf((a), (b)), lo_ = fminf((a), (b)); (a) = hi_; (b) = lo_; } while (0)
template <int N> SEL_HD void bitonic_merge_desc(float (&a)[N]) {
#pragma unroll
    for (int j = N / 2; j >= 1; j >>= 1)
#pragma unroll
        for (int i = 0; i < N; ++i) { const int l = i ^ j; if (l > i) SEL_CE_D(a[i], a[l]); }
}
template <int N> SEL_HD void bitonic_sort_desc(float (&a)[N]) {
#pragma unroll
    for (int k = 2; k <= N; k <<= 1)
#pragma unroll
        for (int j = k / 2; j >= 1; j >>= 1)
#pragma unroll
            for (int i = 0; i < N; ++i) { const int l = i ^ j; if (l > i) { if ((i & k) == 0) SEL_CE_D(a[i], a[l]); else SEL_CE_D(a[l], a[i]); } }
}
SEL_HD void merge_top16(float (&a)[16], const float (&b)[16]) {
#pragma unroll
    for (int i = 0; i < 16; ++i) a[i] = fmaxf(a[i], b[15 - i]);
    bitonic_merge_desc<16>(a);
}
SEL_HD float sel_tag(float v, unsigned mask, unsigned tag) { return __uint_as_float((__float_as_uint(v) & ~mask) | tag); }
SEL_HD void top16_of_64(float (&g)[4][16]) {
    bitonic_sort_desc<16>(g[0]); bitonic_sort_desc<16>(g[1]); bitonic_sort_desc<16>(g[2]); bitonic_sort_desc<16>(g[3]);
    merge_top16(g[0], g[1]); merge_top16(g[2], g[3]); merge_top16(g[0], g[2]);
}
SEL_HD void top16_cross(const float (&lo)[16], const float (&hi)[16], float (&t)[16]) {
#pragma unroll
    for (int i = 0; i < 16; ++i) t[i] = fmaxf(lo[i], hi[15 - i]);
    bitonic_merge_desc<16>(t);
}
SEL_HD void top16_pairs(const float (&t1)[16], const float (&t2)[16], float (&w)[16]) {
    float v1[16], v2[16];
#pragma unroll
    for (int i = 0; i < 16; ++i) { v1[i] = __uint_as_float(__float_as_uint(t1[i]) & ~127u); v2[i] = __uint_as_float(__float_as_uint(t2[i]) & ~127u); }
    const float NEG = -__builtin_inff();
#define SEL_C(i, j) sel_tag(v1[i] + v2[j], 255u, ((i) << 4) | (j))
    float g1[16], g2[16], g3[8];
#pragma unroll
    for (int j = 0; j < 16; ++j) w[j] = SEL_C(0, j);
#pragma unroll
    for (int i = 1; i < 16; ++i) g1[i - 1] = SEL_C(i, 0);
    g1[15] = NEG;
#pragma unroll
    for (int j = 1; j < 8; ++j) g2[j - 1] = SEL_C(1, j);
    g2[7] = NEG; g2[8] = NEG; g2[9] = NEG;
#pragma unroll
    for (int i = 2; i < 8; ++i) g2[17 - i] = SEL_C(i, 1);
    bitonic_merge_desc<16>(g2);
    g3[0] = SEL_C(2, 2); g3[1] = SEL_C(2, 3); g3[2] = SEL_C(2, 4); g3[3] = SEL_C(3, 2); g3[4] = SEL_C(3, 3); g3[5] = SEL_C(4, 2); g3[6] = NEG; g3[7] = NEG;
    bitonic_sort_desc<8>(g3);
#undef SEL_C
    merge_top16(w, g1);
#pragma unroll
    for (int i = 8; i < 16; ++i) g2[i] = fmaxf(g2[i], g3[15 - i]);
    bitonic_merge_desc<16>(g2);
    merge_top16(w, g2);
}
typedef _Float16 h2_t __attribute__((ext_vector_type(2)));
__device__ __forceinline__ float gelu_tanh_f(float x) {
    const float t = x * (1.0f + 0.044715f * x * x) * (-2.3022082f);
    return x * __builtin_amdgcn_rcpf(1.0f + __builtin_amdgcn_exp2f(t));
}
constexpr int SL_KP = 272, SL_KBUF = 128 * SL_KP, SL_OFF_TAB = 2 * SL_KBUF;
static_assert(SL_OFF_TAB + 8 * 2048 <= RING_BYTES, "selection LDS map");
__device__ __forceinline__ void peer_half_top16(const LAS unsigned char* Kb, const bf16* qrow, int hh, float (&Tc)[16]) {
    bf16x8_t qf[8];
#pragma unroll
    for (int ks = 0; ks < 8; ++ks) qf[ks] = *(const bf16x8_t*)(qrow + 16 * ks + 8 * hh);
    float g[4][16];
#pragma unroll
    for (int nb = 0; nb < 4; ++nb) {
        f32x16 sacc;
#pragma unroll
        for (int i = 0; i < 16; ++i) sacc[i] = 0.f;
#pragma unroll
        for (int ks = 0; ks < 8; ++ks) { const bf16x8_t a = *(const LAS bf16x8_t*)(Kb + nb * 32 * SL_KP + 32 * ks); sacc = __builtin_amdgcn_mfma_f32_32x32x16_bf16(a, qf[ks], sacc, 0, 0, 0); }
#pragma unroll
        for (int i = 0; i < 16; ++i) g[nb][i] = __uint_as_float((__float_as_uint(sacc[i]) & ~127u) | (unsigned)(32 * nb + (i & 3) + 8 * (i >> 2) + 4 * hh));
    }
    top16_of_64(g);
    float lo[16], hi[16];
#pragma unroll
    for (int i = 0; i < 16; ++i) { const unsigned x = __float_as_uint(g[0][i]); auto rr = __builtin_amdgcn_permlane32_swap(x, x, false, false); lo[i] = __uint_as_float(rr[0]); hi[i] = __uint_as_float(rr[1]); }
    top16_cross(lo, hi, Tc);
}
__device__ __forceinline__ void peer_select_unit(LAS unsigned char* lds, int tg, int h, const bf16* pq, const float* part2, const bf16* keysb, unsigned* sel_raw, int tid, int lane, int wave) {
    const int r = lane & 31, hh = lane >> 5;
    __syncthreads();
    {
        const bf16* src = keysb + (size_t)h * 2 * 128 * 128;
        v4u kr[8];
#pragma unroll
        for (int i = 0; i < 8; ++i) { const int ch = tid + 512 * i; kr[i] = *(const v4u*)(src + (size_t)ch * 8); }
#pragma unroll
        for (int i = 0; i < 8; ++i) { const int ch = tid + 512 * i, row = ch >> 4, c16 = ch & 15; *(LAS v4u*)(lds + row * SL_KP + c16 * 16) = kr[i]; }
    }
    __syncthreads();
    const int t = tg * 256 + wave * 32 + r;
    float rs2;
    { const f32x4* pp = (const f32x4*)(part2 + (size_t)t * 16); const f32x4 a = pp[0], b = pp[1], c = pp[2], d = pp[3];
      const float ss = ((a[0] + a[1]) + (a[2] + a[3])) + ((b[0] + b[1]) + (b[2] + b[3])) + ((c[0] + c[1]) + (c[2] + c[3])) + ((d[0] + d[1]) + (d[2] + d[3]));
      rs2 = 1.0f / sqrtf(ss * (1.0f / 1024.0f) + EPS); }
    float T0[16], T1[16];
    peer_half_top16(lds + 0 * SL_KBUF + r * SL_KP + 16 * hh, pq + (size_t)t * 2048 + h * 256, hh, T0);
    peer_half_top16(lds + 1 * SL_KBUF + r * SL_KP + 16 * hh, pq + (size_t)t * 2048 + h * 256 + 128, hh, T1);
    float W[16];
    top16_pairs(T0, T1, W);
    LAS unsigned char* tab = lds + SL_OFF_TAB + wave * 2048 + lane;
#pragma unroll
    for (int i = 0; i < 16; ++i) { tab[i * 64] = (unsigned char)(__float_as_uint(T0[i]) & 127u); tab[(16 + i) * 64] = (unsigned char)(__float_as_uint(T1[i]) & 127u); }
    float ex[16]; float sum = 0.f;
    const float sc = rs2 * 1.44269504f, v0 = __uint_as_float(__float_as_uint(W[0]) & ~255u);
#pragma unroll
    for (int k = 0; k < 16; ++k) { const float vk = __uint_as_float(__float_as_uint(W[k]) & ~255u); ex[k] = __builtin_amdgcn_exp2f((vk - v0) * sc); sum += ex[k]; }
    const float isum = 32768.0f / sum;
    LDS_WAIT(); asm volatile("" ::: "memory");
#pragma unroll
    for (int k = 0; k < 16; ++k) {
        const unsigned w = __float_as_uint(W[k]);
        const unsigned n1 = tab[((w >> 4) & 15u) * 64], n2 = tab[(16u + (w & 15u)) * 64];
        unsigned q = (unsigned)(ex[k] * isum + 0.5f); q = q > 32767u ? 32767u : q;
        if ((k >> 3) == hh) sel_raw[(size_t)t * 128 + h * 16 + k] = ((n1 * 128u + n2) << 18) | ((unsigned)(t & 7) << 15) | q;
    }
}

template <int CTRL> __device__ __forceinline__ float dppf(float x) { return __uint_as_float(__builtin_amdgcn_update_dpp(0u, __float_as_uint(x), CTRL, 0xf, 0xf, true)); }
__device__ __forceinline__ void peer_sweep_block(LAS unsigned char* lds, int tok0, const unsigned* sel_raw, unsigned* sel_sorted, const float* part2, const unsigned char* utab, const unsigned char* vtab, const float* tscl, const float* g_ffn,
                                                 float* hio, bf16* hb, float* rs3, int lane, int wave) {
    typedef float f32x2v __attribute__((ext_vector_type(2)));
    const int t0 = tok0 + wave * 8, tk = lane >> 3, j = lane & 7, t = t0 + tk;
    LAS unsigned char* wl = lds + wave * 16384;
    {
        LAS unsigned* cnt = (LAS unsigned*)wl; LAS unsigned* offs = cnt + 512; LAS unsigned* lst = cnt + 1024;
        *(LAS v4u*)(cnt + 8 * lane) = (v4u){0u, 0u, 0u, 0u}; *(LAS v4u*)(cnt + 8 * lane + 4) = (v4u){0u, 0u, 0u, 0u};
        LDS_WAIT(); asm volatile("" ::: "memory");
        unsigned key[16], pos[16];
#pragma unroll
        for (int i = 0; i < 16; ++i) key[i] = sel_raw[(size_t)t0 * 128 + i * 64 + lane];
#pragma unroll
        for (int i = 0; i < 16; ++i) pos[i] = __hip_atomic_fetch_add(cnt + (((key[i] >> 15) & 7u) * 64u + (key[i] >> 26)), 1u, __ATOMIC_RELAXED, __HIP_MEMORY_SCOPE_WORKGROUP);
        LDS_WAIT(); asm volatile("" ::: "memory");
        const v4u c0 = *(const LAS v4u*)(cnt + 8 * lane), c1 = *(const LAS v4u*)(cnt + 8 * lane + 4);
        unsigned ex[8]; ex[0] = 0u; ex[1] = c0[0]; ex[2] = ex[1] + c0[1]; ex[3] = ex[2] + c0[2]; ex[4] = ex[3] + c0[3]; ex[5] = ex[4] + c1[0]; ex[6] = ex[5] + c1[1]; ex[7] = ex[6] + c1[2];
        const unsigned tot = ex[7] + c1[3]; unsigned incl = tot;
#pragma unroll
        for (int o = 1; o < 8; o <<= 1) { const unsigned v = __shfl_up(incl, o, 8); if (j >= o) incl += v; }
        const unsigned gbase = (unsigned)tk * 128u + (incl - tot);
        *(LAS v4u*)(offs + 8 * lane) = (v4u){gbase + ex[0], gbase + ex[1], gbase + ex[2], gbase + ex[3]}; *(LAS v4u*)(offs + 8 * lane + 4) = (v4u){gbase + ex[4], gbase + ex[5], gbase + ex[6], gbase + ex[7]};
        LDS_WAIT(); asm volatile("" ::: "memory");
#pragma unroll
        for (int i = 0; i < 16; ++i) lst[offs[((key[i] >> 15) & 7u) * 64u + (key[i] >> 26)] + pos[i]] = key[i];
        LDS_WAIT(); asm volatile("" ::: "memory");
#pragma unroll
        for (int i = 0; i < 16; ++i) sel_sorted[(size_t)t0 * 128 + i * 64 + lane] = lst[i * 64 + lane];
    }
    asm volatile("s_waitcnt vmcnt(0) lgkmcnt(0)" ::: "memory");
    LAS float* cw = (LAS float*)wl;
    const unsigned* sl = sel_sorted + (size_t)t * 128;
    {
        unsigned xn[8][8];
        { const f32x4* pp = (const f32x4*)(part2 + (size_t)t * 16); const f32x4 a = pp[0], b = pp[1], c = pp[2], d = pp[3];
          const float ss = ((a[0] + a[1]) + (a[2] + a[3])) + ((b[0] + b[1]) + (b[2] + b[3])) + ((c[0] + c[1]) + (c[2] + c[3])) + ((d[0] + d[1]) + (d[2] + d[3]));
          const float rs2 = 1.0f / sqrtf(ss * (1.0f / 1024.0f) + EPS);
#pragma unroll
          for (int k = 0; k < 8; ++k)
#pragma unroll
              for (int q = 0; q < 4; ++q) { const f32x4 x = *(const f32x4*)(hio + (size_t)t * 1024 + k * 128 + j * 16 + 4 * q), g = *(const f32x4*)(g_ffn + k * 128 + j * 16 + 4 * q);
                  const h2_t y0 = (h2_t){(_Float16)(x[0] * rs2 * g[0]), (_Float16)(x[1] * rs2 * g[1])}, y1 = (h2_t){(_Float16)(x[2] * rs2 * g[2]), (_Float16)(x[3] * rs2 * g[3])};
                  xn[k][2 * q] = __builtin_bit_cast(unsigned, y0); xn[k][2 * q + 1] = __builtin_bit_cast(unsigned, y1); } }
#define SW_LOADU(dst, key_) do { const unsigned char* up_ = utab + (size_t)((key_) >> 18) * 1024 + j * 16; _Pragma("unroll") for (int k = 0; k < 8; ++k) dst[k] = *(const v4u*)(up_ + k * 128); } while (0)
#define SW_DOT(Uv, key_, idx_) do { const f32x2v sc_ = *(const f32x2v*)(tscl + 2 * ((key_) >> 18)); const float isu_ = sc_[0]; float dq[4] = {0.f, 0.f, 0.f, 0.f}; \
            _Pragma("unroll") for (int k = 0; k < 8; ++k) _Pragma("unroll") for (int q = 0; q < 4; ++q) { const unsigned uw = Uv[k][q], x0 = xn[k][2 * q], x1 = xn[k][2 * q + 1]; \
                const h2_t ulo = __builtin_amdgcn_cvt_scalef32_pk_f16_fp8(uw, isu_, false), uhi = __builtin_amdgcn_cvt_scalef32_pk_f16_fp8(uw, isu_, true); \
                dq[q] = __builtin_amdgcn_fdot2(ulo, __builtin_bit_cast(h2_t, x0), dq[q], false); dq[q] = __builtin_amdgcn_fdot2(uhi, __builtin_bit_cast(h2_t, x1), dq[q], false); } \
            float d_ = (dq[0] + dq[1]) + (dq[2] + dq[3]); d_ += dppf<0xB1>(d_); d_ += dppf<0x4E>(d_); d_ += dppf<0x141>(d_); \
            const float cf_ = gelu_tanh_f(d_) * ((float)((key_) & 0x7fffu) * (1.0f / 32768.0f)) * sc_[1]; if (j == 0) cw[tk * 128 + (idx_)] = cf_; } while (0)
        v4u Ua[8], Ub[8];
        unsigned ka = sl[0], kb = sl[1];
        SW_LOADU(Ua, ka);
#pragma unroll 1
        for (int i = 0; i < 128; i += 2) {
            SW_LOADU(Ub, kb);
            const unsigned kc = sl[i + 2 < 128 ? i + 2 : 127];
            SW_DOT(Ua, ka, i);
            SW_LOADU(Ua, kc);
            const unsigned kd = sl[i + 3 < 128 ? i + 3 : 127];
            SW_DOT(Ub, kb, i + 1);
            ka = kc; kb = kd;
        }
#undef SW_LOADU
#undef SW_DOT
    }
    LDS_WAIT(); asm volatile("" ::: "memory");
    f32x2v acc[8][8];
#pragma unroll
    for (int k = 0; k < 8; ++k)
#pragma unroll
        for (int p = 0; p < 8; ++p) acc[k][p] = (f32x2v){0.f, 0.f};
    {
#define SW_LOADV(dst, key_) do { const unsigned char* vp_ = vtab + (size_t)((key_) >> 18) * 1024 + j * 16; _Pragma("unroll") for (int k = 0; k < 8; ++k) dst[k] = *(const v4u*)(vp_ + k * 128); } while (0)
#define SW_ACC(Vv, idx_) do { const float cf_ = cw[tk * 128 + (idx_)]; const f32x2v cf2 = {cf_, cf_}; \
            _Pragma("unroll") for (int k = 0; k < 8; ++k) _Pragma("unroll") for (int q = 0; q < 4; ++q) { const unsigned vw = Vv[k][q]; \
                const f32x2v lo = __builtin_amdgcn_cvt_pk_f32_fp8(vw, false), hi = __builtin_amdgcn_cvt_pk_f32_fp8(vw, true); acc[k][2 * q] += cf2 * lo; acc[k][2 * q + 1] += cf2 * hi; } } while (0)
        v4u Va[8], Vb[8];
        unsigned ka = sl[0], kb = sl[1];
        SW_LOADV(Va, ka);
#pragma unroll 1
        for (int i = 0; i < 128; i += 2) {
            SW_LOADV(Vb, kb);
            const unsigned kc = sl[i + 2 < 128 ? i + 2 : 127];
            SW_ACC(Va, i);
            SW_LOADV(Va, kc);
            const unsigned kd = sl[i + 3 < 128 ? i + 3 : 127];
            SW_ACC(Vb, i + 1);
            ka = kc; kb = kd;
        }
#undef SW_LOADV
#undef SW_ACC
    }
    float ss = 0.f;
#pragma unroll
    for (int k = 0; k < 8; ++k) { float* hp = hio + (size_t)t * 1024 + k * 128 + j * 16; bf16* bp = hb + (size_t)t * 1024 + k * 128 + j * 16;
#pragma unroll
        for (int hf = 0; hf < 2; ++hf) { f32x4 a = *(const f32x4*)(hp + 8 * hf), b = *(const f32x4*)(hp + 8 * hf + 4);
            a[0] += acc[k][4 * hf][0]; a[1] += acc[k][4 * hf][1]; a[2] += acc[k][4 * hf + 1][0]; a[3] += acc[k][4 * hf + 1][1];
            b[0] += acc[k][4 * hf + 2][0]; b[1] += acc[k][4 * hf + 2][1]; b[2] += acc[k][4 * hf + 3][0]; b[3] += acc[k][4 * hf + 3][1];
            *(f32x4*)(hp + 8 * hf) = a; *(f32x4*)(hp + 8 * hf + 4) = b; ss += dot4(a, a) + dot4(b, b);
            v4u w; w.x = pk2(a[0], a[1]); w.y = pk2(a[2], a[3]); w.z = pk2(b[0], b[1]); w.w = pk2(b[2], b[3]); *(v4u*)(bp + 8 * hf) = w; } }
    ss += dppf<0xB1>(ss); ss += dppf<0x4E>(ss); ss += dppf<0x141>(ss);
    if (j == 0) rs3[t] = 1.0f / sqrtf(ss * (1.0f / 1024.0f) + EPS);
}

__device__ __forceinline__ void peer_apply_naive(int t, int lane, const unsigned* sel_raw, const float* part2, const float* u_tab, const float* v_tab, const float* g_ffn, float* hio, bf16* hb, float* rs3) {
    float ps = lane < 16 ? part2[(size_t)t * 16 + lane] : 0.f; ps = wave_sum(ps);
    const float rs2 = 1.0f / sqrtf(ps * (1.0f / 1024.0f) + EPS);
    f32x4 hv[4], xn[4], acc[4];
#pragma unroll
    for (int j = 0; j < 4; ++j) { hv[j] = *(const f32x4*)(hio + (size_t)t * 1024 + 256 * j + 4 * lane); const f32x4 gv = *(const f32x4*)(g_ffn + 256 * j + 4 * lane); xn[j] = hv[j] * rs2 * gv; acc[j] = (f32x4){0.f, 0.f, 0.f, 0.f}; }
#pragma unroll 2
    for (int sidx = 0; sidx < 128; ++sidx) {
        const unsigned key = sel_raw[(size_t)t * 128 + sidx]; const int e = key >> 18; const float g = (float)(key & 0x7fffu) * (1.0f / 32768.0f);
        const f32x4* ur = (const f32x4*)(u_tab + (size_t)e * 1024) + lane; const f32x4* vr = (const f32x4*)(v_tab + (size_t)e * 1024) + lane;
        float d = 0.f;
#pragma unroll
        for (int j = 0; j < 4; ++j) d += dot4(ur[64 * j], xn[j]);
        d = wave_sum(d);
        const float coef = g * gelu_tanh_f(d);
#pragma unroll
        for (int j = 0; j < 4; ++j) acc[j] += coef * vr[64 * j];
    }
    float ss = 0.f;
#pragma unroll
    for (int j = 0; j < 4; ++j) { const f32x4 h2 = hv[j] + acc[j]; *(f32x4*)(hio + (size_t)t * 1024 + 256 * j + 4 * lane) = h2; ss += dot4(h2, h2);
        v2u w; w.x = pk2(h2[0], h2[1]); w.y = pk2(h2[2], h2[3]); *(v2u*)(hb + (size_t)t * 1024 + 256 * j + 4 * lane) = w; }
    ss = wave_sum(ss);
    if (lane == 0) rs3[t] = 1.0f / sqrtf(ss * (1.0f / 1024.0f) + EPS);
}
struct Args { const float* in[25]; float* out; unsigned char* ws; int ph_lo, ph_hi; };

#define AS4 __attribute__((address_space(4)))
#define KARGS_HERE const Args AS4* ap = (const Args AS4*)__builtin_amdgcn_kernarg_segment_ptr(); asm volatile("" : "+s"(ap))
__global__ void __launch_bounds__(NWAVES * 64, 2) fwd(Args args) {
    extern __shared__ __attribute__((aligned(16))) unsigned char lds_raw[];
    LAS unsigned char* lds = (LAS unsigned char*)lds_raw;
    volatile LAS unsigned* MISC = (volatile LAS unsigned*)(lds + MISC_OFF);
    const int tid = threadIdx.x, lane = tid & 63, wave = __builtin_amdgcn_readfirstlane(tid >> 6);
    const int G = gridDim.x, bid = blockIdx.x;
    unsigned char* ws = args.ws;
    if (tid < 32) MISC[tid] = 0u;
    __syncthreads();
    XcdBarrier bar; bar.bar = (unsigned*)(ws + WS_CTL); bar.x = 0; bar.st = nullptr;
    if (N_LAUNCHES == 1) bar = xcd_barrier_post((unsigned*)(ws + WS_CTL), MISC + 8);
#define GRID_BAR() do { if (N_LAUNCHES == 1) xcd_barrier(bar); } while (0)
    const int lo = args.ph_lo, hi = args.ph_hi;
#ifndef PROBE_REP_PHASE
#define PROBE_REP_PHASE -1
#endif
#define NREP(k) ((k) == PROBE_REP_PHASE ? 2 : 1)
#ifdef ONLY_PHASE
#define IN(k) ((k) == ONLY_PHASE)
#else
#define IN(k) (lo <= (k) && (k) < hi)
#endif
#define IN_X       (ap->in[0])
#define IN_P       (ap->in[1])
#define IN_GMIX    (ap->in[2])
#define IN_WIN     (ap->in[3])
#define IN_LNG     (ap->in[4])
#define IN_LNB     (ap->in[5])
#define IN_WS      (ap->in[6])
#define IN_BS      (ap->in[7])
#define IN_BETA    (ap->in[8])
#define IN_LQ1     (ap->in[9])
#define IN_LK1     (ap->in[10])
#define IN_LQ2     (ap->in[11])
#define IN_LK2     (ap->in[12])
#define IN_SUBLN   (ap->in[13])
#define IN_RELB    (ap->in[14])
#define IN_WOUT    (ap->in[15])
#define IN_GFFN    (ap->in[16])
#define IN_WQ      (ap->in[17])
#define IN_KEYS    (ap->in[18])
#define IN_UTAB    (ap->in[19])
#define IN_VTAB    (ap->in[20])
#define IN_GPLE    (ap->in[21])
#define IN_WPLE    (ap->in[22])
#define IN_WGATE   (ap->in[23])
#define IN_GFINAL  (ap->in[24])
#define OUTP       (ap->out)
#define Win_t   ((bf16*)(ws + WS_WIN))
#define Wout_t  ((bf16*)(ws + WS_WOUT))
#define Wq_t    ((bf16*)(ws + WS_WQ))
#define Wgate_t ((bf16*)(ws + WS_WGATE))
#define Wple_t  ((bf16*)(ws + WS_WPLE))
#define rs1     ((float*)(ws + WS_RS1))
#define rs3     ((float*)(ws + WS_RS3))
#define part4   ((float*)(ws + WS_PART4))
#define part2   ((float*)(ws + WS_PART2))
#define Abuf    ((bf16*)(ws + WS_A))
#define pb      ((bf16*)(ws + WS_PB))
#define pleb    ((bf16*)(ws + WS_PLE))
#define mix     ((bf16*)(ws + WS_M))
#define pq      ((bf16*)(ws + WS_M))
#define vbuf    ((bf16*)(ws + WS_F))
#define keysb   ((bf16*)(ws + WS_KEYSB))
#define wsb     ((bf16*)(ws + WS_WSB))
#define utab8   ((unsigned char*)(ws + WS_TAB))
#define vtab8   ((unsigned char*)(ws + WS_TAB + 16 * MiB))
#define tabscl  ((float*)(ws + WS_TAB + 32 * MiB))
#define selraw  ((unsigned*)(ws + WS_SEL))
#define selsort ((unsigned*)(ws + WS_SEL + 8 * MiB))
#define zA      ((bf16*)ap->out)
#define qbuf    ((bf16*)((unsigned char*)ap->out + 32 * MiB))
#define kbuf    ((bf16*)((unsigned char*)ap->out + 48 * MiB))
    const int gw = bid * NWAVES + wave, NGW = G * NWAVES;

    if (IN(0)) { KARGS_HERE;
        _Pragma("unroll") for (int rep_ = 0; rep_ < NREP(0); ++rep_) {
        LAS float* scr = (LAS float*)(lds + wave * 16384);
        constexpr int I_IN = 16 * 80, I_OUT = 16 * 32, I_Q = 16 * 64, I_G = 16 * 32, I_P = 4 * 32;
        for (int it = gw; it < I_IN + I_OUT + I_Q + I_G + I_P; it += NGW) {
            int r = it;
            if (r < I_IN) { p0_transpose_item(IN_WIN, IN_GMIX, 1024, 2560, Win_t, scr, r, lane); continue; } r -= I_IN;
            if (r < I_OUT) { p0_transpose_item(IN_WOUT, nullptr, 1024, 1024, Wout_t, scr, r, lane); continue; } r -= I_OUT;
            if (r < I_Q) { p0_transpose_item(IN_WQ, IN_GFFN, 1024, 2048, Wq_t, scr, r, lane); continue; } r -= I_Q;
            if (r < I_G) { p0_transpose_item(IN_WGATE, IN_GPLE, 1024, 1024, Wgate_t, scr, r, lane); continue; } r -= I_G;
            p0_transpose_item(IN_WPLE, nullptr, 256, 1024, Wple_t, scr, r, lane);
        }
        for (int m = gw; m < T; m += NGW) {
            const f32x4* xr = (const f32x4*)(IN_X + (size_t)m * D) + lane; f32x4 v[4]; float s = 0.f;
#pragma unroll
            for (int j = 0; j < 4; ++j) { v[j] = xr[64 * j]; s += dot4(v[j], v[j]); }
            s = wave_sum(s);
            if (lane == 0) rs1[m] = 1.0f / sqrtf(s * (1.0f / 1024.0f) + EPS);
            v2u* o = (v2u*)(Abuf + (size_t)m * D) + lane;
#pragma unroll
            for (int j = 0; j < 4; ++j) { v2u w; w.x = pk2(v[j][0], v[j][1]); w.y = pk2(v[j][2], v[j][3]); o[64 * j] = w; }
            const f32x4 pv = *((const f32x4*)(IN_P + (size_t)m * 256) + lane); v2u w; w.x = pk2(pv[0], pv[1]); w.y = pk2(pv[2], pv[3]); *((v2u*)(pb + (size_t)m * 256) + lane) = w;
        }
        {
            const size_t gt = (size_t)bid * (NWAVES * 64) + tid, GT = (size_t)G * (NWAVES * 64);
            for (size_t i = gt; i < (size_t)(8 * 2 * 128 * 128 / 8); i += GT) { const f32x4 a = *((const f32x4*)IN_KEYS + 2 * i), b = *((const f32x4*)IN_KEYS + 2 * i + 1);
                v4u w; w.x = pk2(a[0], a[1]); w.y = pk2(a[2], a[3]); w.z = pk2(b[0], b[1]); w.w = pk2(b[2], b[3]); *((v4u*)keysb + i) = w; }
            for (size_t i = gt; i < (size_t)(4 * 128 * 128 / 8); i += GT) { const f32x4 a = *((const f32x4*)IN_WS + 2 * i), b = *((const f32x4*)IN_WS + 2 * i + 1);
                v4u w; w.x = pk2(a[0], a[1]); w.y = pk2(a[2], a[3]); w.z = pk2(b[0], b[1]); w.w = pk2(b[2], b[3]); *((v4u*)wsb + i) = w; }
        }
        for (int row = gw; row < 2 * 16384; row += NGW) {
            const int e = row >> 1, isv = row & 1;
            const float* src = (isv ? IN_VTAB : IN_UTAB) + (size_t)e * 1024 + 16 * lane;
            f32x4 v[4]; float am = 0.f;
#pragma unroll
            for (int j = 0; j < 4; ++j) { v[j] = *(const f32x4*)(src + 4 * j); am = fmaxf(am, fmaxf(fmaxf(fabsf(v[j][0]), fabsf(v[j][1])), fmaxf(fabsf(v[j][2]), fabsf(v[j][3])))); }
#pragma unroll
            for (int o = 1; o < 64; o <<= 1) am = fmaxf(am, __shfl_xor(am, o));
            const int ex = (int)((__float_as_uint(am) >> 23) & 0xffu);
            const bool ok = ex >= 8 && ex < 255;
            const float sc = ok ? __uint_as_float((unsigned)(261 - ex) << 23) : 1.0f;
            const float isc = ok ? __uint_as_float((unsigned)(ex - 7) << 23) : 1.0f;
            v4u w;
#pragma unroll
            for (int j = 0; j < 4; ++j) { unsigned p = __builtin_amdgcn_cvt_pk_fp8_f32(v[j][0] * sc, v[j][1] * sc, 0u, false); p = __builtin_amdgcn_cvt_pk_fp8_f32(v[j][2] * sc, v[j][3] * sc, p, true); w[j] = p; }
            *(v4u*)((isv ? vtab8 : utab8) + (size_t)e * 1024 + 16 * lane) = w;
            if (lane == 0) tabscl[2 * e + isv] = isc;
        }
        if (rep_ + 1 < NREP(0)) { __syncthreads(); } }
        if (IN(1)) GRID_BAR();
    }
    if (IN(1)) { KARGS_HERE;
        _Pragma("unroll") for (int rep_ = 0; rep_ < NREP(1); ++rep_) {
        { pg8::Gemm g{Abuf, Win_t, T, 2560, 1024}; pg8::StaticOrder S; S.init(T, 2560, G, bid);
          pg8::EpiZ E{zA, qbuf, kbuf, vbuf, rs1, 0.125f * 1.44269504f};
          pg8::gemm_phase<pg8::EpiZ, pg8::StaticOrder, true, true>(lds, g, S, E); }
        { pg8::Gemm g{pb, Wple_t, T, 1024, 256}; pg8::StaticOrder S; S.init(T, 1024, G, bid);
          pg8::EpiBf E{pleb, 1024};
          pg8::gemm_phase<pg8::EpiBf, pg8::StaticOrder, true, true>(lds, g, S, E); }
        if (rep_ + 1 < NREP(1)) { __syncthreads(); } }
        if (IN(2)) GRID_BAR();
    }
    if (IN(2)) { KARGS_HERE;
        _Pragma("unroll") for (int rep_ = 0; rep_ < NREP(2); ++rep_) {
        for (int up = bid; up < 256; up += G) gmlp_pair(lds, up, zA, IN_LNG, IN_LNB, wsb, IN_BS, IN_BETA, mix, lane, wave);
        float lam;
        { const float a = IN_LQ1[lane] * IN_LK1[lane], b2 = IN_LQ2[lane] * IN_LK2[lane]; lam = __expf(wave_sum(a)) - __expf(wave_sum(b2)) + 0.2f; }
        for (int i = 0; i < 2; ++i) { const int u = i * G + bid; if (u >= 512) break;
            const int bh = u & 15, jp = (u >> 4) & 15, jb = (u < 256) ? 31 - jp : jp;
            attn_unit(lds, bh >> 2, bh & 3, jb, qbuf, kbuf, vbuf, IN_RELB, lam, IN_SUBLN, mix, tid, lane, wave); }
        if (rep_ + 1 < NREP(2)) { __syncthreads(); } }
        if (IN(3)) GRID_BAR();
    }
    if (IN(3)) { KARGS_HERE;
        _Pragma("unroll") for (int rep_ = 0; rep_ < NREP(3); ++rep_) {
        pg8::Gemm g{mix, Wout_t, T, 1024, 1024}; pg8::StaticOrder S; S.init(T, 1024, G, bid);
        pg8::EpiRes E{IN_X, OUTP, Abuf, part2};
        pg8::gemm_phase<pg8::EpiRes, pg8::StaticOrder, true, true>(lds, g, S, E);
        if (rep_ + 1 < NREP(3)) { __syncthreads(); } }
        if (IN(4)) GRID_BAR();
    }
    if (IN(4)) { KARGS_HERE;
        _Pragma("unroll") for (int rep_ = 0; rep_ < NREP(4); ++rep_) {
        pg8::Gemm g{Abuf, Wq_t, T, 2048, 1024}; pg8::StaticOrder S; S.init(T, 2048, G, bid);
        pg8::EpiBf E{pq, 2048};
        pg8::gemm_phase<pg8::EpiBf, pg8::StaticOrder, true, true>(lds, g, S, E);
        if (rep_ + 1 < NREP(4)) { __syncthreads(); } }
        if (IN(5)) GRID_BAR();
    }
    if (IN(5)) { KARGS_HERE;
        _Pragma("unroll") for (int rep_ = 0; rep_ < NREP(5); ++rep_) {
        for (int u = bid; u < 512; u += G) peer_select_unit(lds, u >> 3, u & 7, pq, part2, keysb, selraw, tid, lane, wave);
        if (rep_ + 1 < NREP(5)) { __syncthreads(); } }
        if (IN(6)) GRID_BAR();
    }
    if (IN(6)) { KARGS_HERE;
#ifdef DBG_NAIVE_APPLY
        for (int t = gw; t < T; t += NGW) peer_apply_naive(t, lane, selraw, part2, IN_UTAB, IN_VTAB, IN_GFFN, OUTP, Abuf, rs3);
#else
        for (int tb = bid; tb < T / 64; tb += G) { __syncthreads(); peer_sweep_block(lds, tb * 64, selraw, selsort, part2, utab8, vtab8, tabscl, IN_GFFN, OUTP, Abuf, rs3, lane, wave); }
#endif
        if (IN(7)) GRID_BAR();
    }
    if (IN(7)) { KARGS_HERE;
        pg8::Gemm g{Abuf, Wgate_t, T, 1024, 1024}; pg8::StaticOrder S; S.init(T, 1024, G, bid);
        pg8::EpiGate E{OUTP, pleb, rs3, part4};
        pg8::gemm_phase<pg8::EpiGate, pg8::StaticOrder, true, true>(lds, g, S, E);
        if (IN(8)) GRID_BAR();
    }
    if (IN(8)) { KARGS_HERE;
        for (int m = gw; m < T; m += NGW) {
            float ps = lane < 16 ? part4[(size_t)m * 16 + lane] : 0.f; ps = wave_sum(ps);
            const float r = 1.0f / sqrtf(ps * (1.0f / 1024.0f) + EPS);
            f32x4* hr = (f32x4*)(OUTP + (size_t)m * D) + lane;
#pragma unroll
            for (int j = 0; j < 4; ++j) { const f32x4 gv = *((const f32x4*)IN_GFINAL + 64 * j + lane); hr[64 * j] = hr[64 * j] * r * gv; }
        }
    }
#undef IN
#undef GRID_BAR
}

extern "C" void kernel_launch(void* const* d_in, const int* in_sizes, int n_in, void* d_out, int out_size, void* d_ws, size_t ws_size, hipStream_t stream) {
    static int grid = 0;
    if (grid == 0) {
        if (n_in != 25 || out_size != T * D || ws_size < WS_END) { fprintf(stderr, "kernel_launch: unexpected shapes (n_in %d, out %d, ws %zu)\n", n_in, out_size, ws_size); grid = -1; return; }
        int dev = 0, cus = 0, per_cu = 0;
        if (hipGetDevice(&dev) != hipSuccess || hipDeviceGetAttribute(&cus, hipDeviceAttributeMultiprocessorCount, dev) != hipSuccess) { grid = -1; return; }
        if (hipFuncSetAttribute((const void*)fwd, hipFuncAttributeMaxDynamicSharedMemorySize, LDS_BYTES) != hipSuccess) { fprintf(stderr, "kernel_launch: hipFuncSetAttribute failed\n"); grid = -1; return; }
        if (hipOccupancyMaxActiveBlocksPerMultiprocessor(&per_cu, (const void*)fwd, NWAVES * 64, LDS_BYTES) != hipSuccess || per_cu < 1) { fprintf(stderr, "kernel_launch: occupancy query says %d blocks per CU\n", per_cu); }
        (void)hipGetLastError();
        grid = cus;
    }
    if (grid < 0) return;
    if (N_LAUNCHES == 1) (void)hipMemsetAsync((char*)d_ws + WS_CTL, 0, CTL_ZERO_BYTES, stream);
    Args a{};
    for (int i = 0; i < 25; ++i) a.in[i] = (const float*)d_in[i];
    a.out = (float*)d_out; a.ws = (unsigned char*)d_ws;
    if (N_LAUNCHES == 1) { a.ph_lo = 0; a.ph_hi = NPHASE; hipLaunchKernelGGL(fwd, dim3(grid), dim3(NWAVES * 64), LDS_BYTES, stream, a); }
    else for (int li = 0; li < NPHASE; ++li) { a.ph_lo = li; a.ph_hi = li + 1; hipLaunchKernelGGL(fwd, dim3(grid), dim3(NWAVES * 64), LDS_BYTES, stream, a); }
}
```
